# Optimizing an MI355X kernel written in HIP

```python
import math
import jax, jax.numpy as jnp
from jax import lax
import numpy as np

D_MODEL = 1024
BATCH = 4
SEQ = 8192
DEPTH = 1
DEC_BATCH = 32
DEC_SEQ = 64
PAST_LEN = 1024

CHUNK = 64
N_HEADS = 8
HEAD_DIM = 64
V_DIM = 2 * HEAD_DIM
QK_COLS = N_HEADS * 2 * HEAD_DIM
ATTN_DIM = N_HEADS * V_DIM
CONV_DIM = D_MODEL
CONV_W = 3
D_FF = 2816
Q_BLOCK = 128
EPS = 1e-6
NEG = -1e30
SPLITS = [int(s) for s in np.cumsum([QK_COLS, QK_COLS, ATTN_DIM, CONV_DIM, CONV_DIM, CONV_DIM, D_MODEL])]
IN_COLS = 2 * QK_COLS + ATTN_DIM + 3 * CONV_DIM + 2 * D_MODEL

kernel_name = "hybrid_diffattn_shortconv_macaron_step"


def rmsnorm(x, g):
    xf = x.astype(jnp.float32)
    y = xf * lax.rsqrt(jnp.mean(xf * xf, axis=-1, keepdims=True) + EPS)
    return (y * g.astype(jnp.float32)).astype(x.dtype)


def swiglu(x, w_gate, w_up, w_down):
    return (jax.nn.silu(x @ w_gate) * (x @ w_up)) @ w_down


def lambda_init_fn(layer_idx):
    return 0.8 - 0.6 * math.exp(-0.3 * layer_idx)


def diff_attn_core(q, k, v, lam, mask):
    s = jnp.einsum('bqhmd,bkhmd->bhmqk', q, k).astype(jnp.float32) * (HEAD_DIM ** -0.5)
    if mask is not None:
        s = jnp.where(mask, s, NEG)
    p = jax.nn.softmax(s, axis=-1)
    a = p[:, :, 0] - lam * p[:, :, 1]
    return jnp.einsum('bhqk,bkhv->bqhv', a.astype(v.dtype), v)


def prompt_attention(q, k, v, lam):
    Bn, S = q.shape[0], q.shape[1]
    kpos_chunk = jnp.arange(S) // CHUNK

    def block(i):
        start = i * Q_BLOCK
        qb = lax.dynamic_slice_in_dim(q, start, Q_BLOCK, axis=1)
        qchunk = (start + jnp.arange(Q_BLOCK)) // CHUNK
        mask = kpos_chunk[None, :] <= qchunk[:, None]
        return diff_attn_core(qb, k, v, lam, mask)

    out = lax.map(block, jnp.arange(S // Q_BLOCK))
    return jnp.moveaxis(out, 0, 1).reshape(Bn, S, N_HEADS, V_DIM)


def token_mix(h, layer_idx, conv_prev, past_k, past_v, w_in, b_gate, lq1, lk1, lq2, lk2,
              subln_g, w_attn_out, conv_w, conv_b, w_conv_out, w_mix_out):
    Bn, T, _ = h.shape
    z = h @ w_in
    q, k, v, cb, cc, ch, ga, gb = jnp.split(z, SPLITS, axis=-1)
    q = q.reshape(Bn, T, N_HEADS, 2, HEAD_DIM)
    k = k.reshape(Bn, T, N_HEADS, 2, HEAD_DIM)
    v = v.reshape(Bn, T, N_HEADS, V_DIM)
    lam_init = lambda_init_fn(layer_idx)
    lam = (jnp.exp(jnp.sum(lq1.astype(jnp.float32) * lk1.astype(jnp.float32)))
           - jnp.exp(jnp.sum(lq2.astype(jnp.float32) * lk2.astype(jnp.float32))) + lam_init)
    if past_k is None:
        o = prompt_attention(q, k, v, lam)
    else:
        k_all = jnp.concatenate([past_k, k], axis=1)
        v_all = jnp.concatenate([past_v, v], axis=1)
        o = diff_attn_core(q, k_all, v_all, lam, None)
    o = (rmsnorm(o, subln_g) * (1.0 - lam_init)).astype(h.dtype).reshape(Bn, T, ATTN_DIM)
    y_attn = o @ w_attn_out

    u = cc * ch
    if conv_prev is None:
        conv_prev = jnp.zeros((Bn, CONV_W - 1, CONV_DIM), u.dtype)
    padded = jnp.concatenate([conv_prev.astype(u.dtype), u], axis=1)
    zc = conv_b
    for j in range(CONV_W):
        zc = zc + conv_w[j] * padded[:, j:j + T]
    y_conv = (cb * zc) @ w_conv_out
    new_conv = padded[:, -(CONV_W - 1):]

    g = jax.nn.sigmoid((jnp.concatenate([ga, gb], axis=-1) + b_gate).astype(jnp.float32)).astype(h.dtype)
    g_a, g_b = g[..., :D_MODEL], g[..., D_MODEL:]
    y = (g_a * y_attn + g_b * y_conv) @ w_mix_out
    return y, k, v, new_conv


def setup_inputs(seed: int = 0) -> dict:
    key = jax.random.key(seed)
    ks = jax.random.split(key, 32)
    f32 = jnp.float32
    nrm = lambda k, shape, s: jax.random.normal(k, shape, f32) * s
    gain = lambda k, n: 1.0 + 0.02 * jax.random.normal(k, (DEPTH, n), f32)
    return {
        "x_prompt": nrm(ks[0], (BATCH, SEQ, D_MODEL), 1.0),
        "x_sample": nrm(ks[1], (DEC_BATCH, DEC_SEQ, D_MODEL), 1.0),
        "cache_k": nrm(ks[2], (DEPTH, DEC_BATCH, PAST_LEN, N_HEADS, 2, HEAD_DIM), 1.0),
        "cache_v": nrm(ks[3], (DEPTH, DEC_BATCH, PAST_LEN, N_HEADS, V_DIM), 1.0),
        "state_conv": nrm(ks[4], (DEPTH, DEC_BATCH, CONV_W - 1, CONV_DIM), 1.0),
        "ffn1_norm_pre": gain(ks[5], D_MODEL),
        "ffn1_norm_post": gain(ks[6], D_MODEL),
        "ffn1_w_gate": nrm(ks[7], (DEPTH, D_MODEL, D_FF), D_MODEL ** -0.5),
        "ffn1_w_up": nrm(ks[8], (DEPTH, D_MODEL, D_FF), D_MODEL ** -0.5),
        "ffn1_w_down": nrm(ks[9], (DEPTH, D_FF, D_MODEL), D_FF ** -0.5),
        "mix_norm_pre": gain(ks[10], D_MODEL),
        "mix_norm_post": gain(ks[11], D_MODEL),
        "w_in": nrm(ks[12], (DEPTH, D_MODEL, IN_COLS), D_MODEL ** -0.5),
        "b_gate": nrm(ks[13], (DEPTH, 2 * D_MODEL), 0.02),
        "lambda_q1": nrm(ks[14], (DEPTH, HEAD_DIM), 0.1),
        "lambda_k1": nrm(ks[15], (DEPTH, HEAD_DIM), 0.1),
        "lambda_q2": nrm(ks[16], (DEPTH, HEAD_DIM), 0.1),
        "lambda_k2": nrm(ks[17], (DEPTH, HEAD_DIM), 0.1),
        "subln_g": gain(ks[18], V_DIM),
        "w_attn_out": nrm(ks[19], (DEPTH, ATTN_DIM, D_MODEL), ATTN_DIM ** -0.5),
        "conv_w": nrm(ks[20], (DEPTH, CONV_W, CONV_DIM), CONV_W ** -0.5),
        "conv_b": nrm(ks[21], (DEPTH, CONV_DIM), 0.02),
        "w_conv_out": nrm(ks[22], (DEPTH, CONV_DIM, D_MODEL), CONV_DIM ** -0.5),
        "w_mix_out": nrm(ks[23], (DEPTH, D_MODEL, D_MODEL), D_MODEL ** -0.5),
        "ffn2_norm_pre": gain(ks[24], D_MODEL),
        "ffn2_norm_post": gain(ks[25], D_MODEL),
        "ffn2_w_gate": nrm(ks[26], (DEPTH, D_MODEL, D_FF), D_MODEL ** -0.5),
        "ffn2_w_up": nrm(ks[27], (DEPTH, D_MODEL, D_FF), D_MODEL ** -0.5),
        "ffn2_w_down": nrm(ks[28], (DEPTH, D_FF, D_MODEL), D_FF ** -0.5),
    }


def reference(x_prompt, x_sample, cache_k, cache_v, state_conv,
              ffn1_norm_pre, ffn1_norm_post, ffn1_w_gate, ffn1_w_up, ffn1_w_down,
              mix_norm_pre, mix_norm_post, w_in, b_gate,
              lambda_q1, lambda_k1, lambda_q2, lambda_k2, subln_g, w_attn_out,
              conv_w, conv_b, w_conv_out, w_mix_out,
              ffn2_norm_pre, ffn2_norm_post, ffn2_w_gate, ffn2_w_up, ffn2_w_down):

    def run_layer(x, l, conv_prev, past_k, past_v):
        h = rmsnorm(x, ffn1_norm_pre[l])
        x = x + 0.5 * rmsnorm(swiglu(h, ffn1_w_gate[l], ffn1_w_up[l], ffn1_w_down[l]), ffn1_norm_post[l])
        h = rmsnorm(x, mix_norm_pre[l])
        y, k, v, c = token_mix(h, l, conv_prev, past_k, past_v, w_in[l], b_gate[l],
                               lambda_q1[l], lambda_k1[l], lambda_q2[l], lambda_k2[l],
                               subln_g[l], w_attn_out[l], conv_w[l], conv_b[l],
                               w_conv_out[l], w_mix_out[l])
        x = x + rmsnorm(y, mix_norm_post[l])
        h = rmsnorm(x, ffn2_norm_pre[l])
        x = x + 0.5 * rmsnorm(swiglu(h, ffn2_w_gate[l], ffn2_w_up[l], ffn2_w_down[l]), ffn2_norm_post[l])
        return x, k, v, c

    xp, xs = x_prompt, x_sample
    kp_l, vp_l, cp_l, ks_l, vs_l, cs_l = [], [], [], [], [], []
    for l in range(DEPTH):
        xp, kp, vp, cp = run_layer(xp, l, None, None, None)
        xs, ksm, vsm, csm = run_layer(xs, l, state_conv[l], cache_k[l], cache_v[l])
        kp_l.append(kp); vp_l.append(vp); cp_l.append(cp)
        ks_l.append(ksm); vs_l.append(vsm); cs_l.append(csm)
    new_k_prompt = jnp.stack(kp_l)
    new_v_prompt = jnp.stack(vp_l)
    new_conv_prompt = jnp.stack(cp_l)
    new_k_sample = jnp.stack(ks_l)
    new_v_sample = jnp.stack(vs_l)
    new_conv_sample = jnp.stack(cs_l)
    return (xp, xs, new_k_prompt, new_v_prompt, new_conv_prompt, new_k_sample, new_v_sample, new_conv_sample)
```

```cpp
#include <hip/hip_runtime.h>
#include <hip/hip_cooperative_groups.h>
#include <cstdio>
#include <cstdint>
namespace cg = cooperative_groups;
namespace pg8 {
#define PG8_LAS __attribute__((address_space(3)))
typedef unsigned short bf16_t;
typedef short bf16x8 __attribute__((ext_vector_type(8)));
typedef float f32x4 __attribute__((ext_vector_type(4)));
typedef unsigned u32x4 __attribute__((ext_vector_type(4)));
constexpr int BM = 256, BK = 64, HALF = 128, HTB = HALF * BK * 2  , STAGE_BYTES = 8 * HTB, NXCD = 8, WGM = 8;

__host__ __device__ __forceinline__ int lds_byte(int r, int c) { const int st = (r >> 4) * 2 + (c >> 5), rr = r & 15, cc = c & 31, ob = rr * 64 + cc * 2; return st * 1024 + (ob ^ (((ob >> 9) & 1) << 5)); }
__host__ __device__ __forceinline__ void stage_rc(int b, int& R, int& C) { const int st = b / 1024, sb = b % 1024, swz = sb ^ (((sb >> 9) & 1) << 5); R = (st >> 1) * 16 + swz / 64; C = (st & 1) * 32 + (swz % 64) / 2; }
__host__ __device__ __forceinline__ int perm32(int rho) { const int n = rho >> 4, i = rho & 15; return 8 * (i >> 2) + 4 * n + (i & 3); }

struct Unit { int pm, pn; };
struct Gemm { const bf16_t* A; const bf16_t* Bt; int M, N, K; const bf16_t* A2; int a2pn; };

struct StaticOrder {
    int nM, nN, nwg, G, c;
    __host__ __device__ void init(int M, int N, int G_, int c_) { nM = M / BM; nN = N / BM; nwg = nM * nN; G = G_; c = c_; }
    __host__ __device__ bool next(int i, Unit& u) const {
        const long L = (long)i * G + c; if (L >= nwg) return false;
        int wgid = (int)L; { const int q = nwg / NXCD, r = nwg % NXCD, xcd = wgid % NXCD, off = wgid / NXCD; wgid = (xcd < r ? xcd * (q + 1) : r * (q + 1) + (xcd - r) * q) + off; }
        const int nig = WGM * nN, gid = wgid / nig, fm = gid * WGM, gsz = (nM - fm) < WGM ? (nM - fm) : WGM;
        u.pm = fm + ((wgid % nig) % gsz); u.pn = (wgid % nig) / gsz; return true;
    }
    __device__ __forceinline__ void a_ready(const Unit&) const {}
    __device__ __forceinline__ void done(const Unit&) const {}
};

__device__ __forceinline__ unsigned cvt_pk_bf16(float lo, float hi) { unsigned r; asm volatile("v_cvt_pk_bf16_f32 %0, %1, %2" : "=v"(r) : "v"(lo), "v"(hi)); return r; }
template <class Epi, class Sched, bool ALIGN_EPI = false, bool SP2 = false>
__device__ __forceinline__ void gemm_phase(PG8_LAS unsigned char* lds, const Gemm g, const Sched& S, const Epi& E) {
    int tid_l = threadIdx.x; asm volatile("" : "+v"(tid_l));
    const int tid = tid_l, wid = __builtin_amdgcn_readfirstlane(tid >> 6), lane = tid & 63, wr = wid >> 2, wc = wid & 3, fr = lane & 15, fq = lane >> 4;
    const int K = g.K, nt = K / BK;
    unsigned voffA[2], voffB[2];
#pragma unroll
    for (int i = 0; i < 2; ++i) { int R, C; stage_rc(tid * 16 + i * 8192, R, C); const int Rb = Epi::PERM ? ((R & ~31) + perm32(R & 31)) : R;
        voffA[i] = (unsigned)(R * K + C) * 2u; voffB[i] = (unsigned)(Rb * K + C) * 2u; }
    const size_t kstep = (size_t)(BK * 2);
    const size_t hstep = (size_t)HALF * K * 2;
    const size_t tstep = 2 * hstep;
    const unsigned ldsw = (unsigned)wid * 1024u;
    const int aoff = lds_byte(wr * 64 + fr, fq * 8), boff = lds_byte(wc * 32 + fr, fq * 8);
#define PG8_SA(b, h) (((b) * 2 + (h)) * HTB)
#define PG8_SB(b, h) ((4 + (b) * 2 + (h)) * HTB)
#define PG8_STAGE(bufoff, gbase, voff) do { _Pragma("unroll") for (int _i = 0; _i < 2; ++_i) \
        __builtin_amdgcn_global_load_lds((const unsigned*)((const char*)(gbase) + (voff)[_i]), (PG8_LAS unsigned*)(lds + (bufoff) + ldsw + _i * 8192), 16, 0, 0); } while (0)
#define PG8_LDA(dst, b, h) do { _Pragma("unroll") for (int m = 0; m < 4; ++m) _Pragma("unroll") for (int k = 0; k < 2; ++k) dst[m][k] = *(const PG8_LAS bf16x8*)(lds + PG8_SA(b, h) + aoff + m * 2048 + k * 1024); } while (0)
#define PG8_LDB(dst, b, h) do { _Pragma("unroll") for (int n = 0; n < 2; ++n) _Pragma("unroll") for (int k = 0; k < 2; ++k) dst[n][k] = *(const PG8_LAS bf16x8*)(lds + PG8_SB(b, h) + boff + n * 2048 + k * 1024); } while (0)
#define PG8_MMA(ai, bj, At, Bt) do { __builtin_amdgcn_s_setprio(1); _Pragma("unroll") for (int m = 0; m < 4; ++m) _Pragma("unroll") for (int n = 0; n < 2; ++n) _Pragma("unroll") for (int k = 0; k < 2; ++k) \
        acc[ai][bj][m][n] = __builtin_amdgcn_mfma_f32_16x16x32_bf16(Bt[n][k], At[m][k], acc[ai][bj][m][n], 0, 0, 0); __builtin_amdgcn_s_setprio(0); } while (0)
#define PG8_WAIT_V(n) asm volatile("s_waitcnt vmcnt(" #n ")" ::: "memory")
#define PG8_WAIT_L(n) asm volatile("s_waitcnt lgkmcnt(" #n ")" ::: "memory")
#define PG8_BAR __builtin_amdgcn_s_barrier()
#define PG8_SCHED __builtin_amdgcn_sched_barrier(0)
    Unit cur, nxt; int ui = 0;
    if (!S.next(0, cur)) return;
    f32x4 acc[2][2][4][2];
#pragma unroll
    for (int a = 0; a < 2; ++a)
#pragma unroll
        for (int b = 0; b < 2; ++b)
#pragma unroll
            for (int m = 0; m < 4; ++m)
#pragma unroll
                for (int n = 0; n < 2; ++n) acc[a][b][m][n] = (f32x4){0.f, 0.f, 0.f, 0.f};
    bf16x8 At[4][2], B0[2][2], B1[2][2];
    const char* cA = (const char*)(cur.pn >= g.a2pn ? g.A2 : g.A) + (size_t)cur.pm * tstep; const char* cB = (const char*)g.Bt + (size_t)cur.pn * tstep;
    S.a_ready(cur);
    if constexpr (SP2) {
        PG8_STAGE(PG8_SB(0, 0), cB, voffB); PG8_STAGE(PG8_SB(0, 1), cB + hstep, voffB); PG8_STAGE(PG8_SA(0, 0), cA, voffA); PG8_STAGE(PG8_SA(0, 1), cA + hstep, voffA);
        if (wr == 1) PG8_BAR;
        PG8_WAIT_V(2); PG8_BAR;
        PG8_STAGE(PG8_SB(1, 0), cB + kstep, voffB); PG8_STAGE(PG8_SA(1, 0), cA + kstep, voffA); PG8_STAGE(PG8_SB(1, 1), cB + hstep + kstep, voffB);
        PG8_WAIT_V(6); PG8_BAR;
    } else {
        PG8_STAGE(PG8_SB(0, 0), cB, voffB); PG8_STAGE(PG8_SA(0, 0), cA, voffA); PG8_STAGE(PG8_SB(0, 1), cB + hstep, voffB); PG8_STAGE(PG8_SA(0, 1), cA + hstep, voffA);
        if (wr == 1) PG8_BAR;
        PG8_WAIT_V(4); PG8_BAR;
        PG8_STAGE(PG8_SB(1, 0), cB + kstep, voffB); PG8_STAGE(PG8_SA(1, 0), cA + kstep, voffA); PG8_STAGE(PG8_SB(1, 1), cB + hstep + kstep, voffB);
        PG8_WAIT_V(6); PG8_BAR;
    }
    for (;;) {
        const bool has_next = S.next(ui + 1, nxt);
        const char* nA = has_next ? (const char*)(nxt.pn >= g.a2pn ? g.A2 : g.A) + (size_t)nxt.pm * tstep : cA; const char* nB = has_next ? (const char*)g.Bt + (size_t)nxt.pn * tstep : cB;
        for (int t = 0; t < nt; t += 2) {
            const bool last = (t == nt - 2);
            const char* a1 = cA + (size_t)(t + 1) * kstep;
            const char* a2 = last ? nA : cA + (size_t)(t + 2) * kstep; const char* b2 = last ? nB : cB + (size_t)(t + 2) * kstep;
            const char* a3 = a2 + kstep; const char* b3 = b2 + kstep;
            if (last && has_next) S.a_ready(nxt);
            if constexpr (SP2) {
            PG8_LDB(B0, 0, 0); PG8_LDB(B1, 0, 1); PG8_SCHED; PG8_LDA(At, 0, 0); PG8_STAGE(PG8_SA(1, 1), a1 + hstep, voffA);
            PG8_WAIT_V(8); PG8_WAIT_L(0); PG8_BAR; PG8_MMA(0, 0, At, B0); PG8_MMA(0, 1, At, B1); PG8_BAR; PG8_SCHED;
            PG8_LDA(At, 0, 1); PG8_STAGE(PG8_SB(0, 0), b2, voffB); PG8_STAGE(PG8_SB(0, 1), b2 + hstep, voffB); PG8_STAGE(PG8_SA(0, 0), a2, voffA);
            PG8_WAIT_V(8); PG8_WAIT_L(0); PG8_BAR; PG8_MMA(1, 0, At, B0); PG8_MMA(1, 1, At, B1); PG8_BAR; PG8_SCHED;
            PG8_LDB(B0, 1, 0); PG8_LDB(B1, 1, 1); PG8_SCHED; PG8_LDA(At, 1, 0); PG8_STAGE(PG8_SA(0, 1), a2 + hstep, voffA);
            PG8_WAIT_V(8); PG8_WAIT_L(0); PG8_BAR; PG8_MMA(0, 0, At, B0); PG8_MMA(0, 1, At, B1); PG8_BAR; PG8_SCHED;
            PG8_LDA(At, 1, 1); PG8_STAGE(PG8_SB(1, 0), b3, voffB); PG8_STAGE(PG8_SB(1, 1), b3 + hstep, voffB); PG8_STAGE(PG8_SA(1, 0), a3, voffA);
            PG8_WAIT_V(8); PG8_WAIT_L(0); PG8_BAR; PG8_MMA(1, 0, At, B0); PG8_MMA(1, 1, At, B1); PG8_BAR; PG8_SCHED;
            } else {
            PG8_LDB(B0, 0, 0); PG8_SCHED; PG8_LDA(At, 0, 0); PG8_STAGE(PG8_SA(1, 1), a1 + hstep, voffA);
            PG8_WAIT_L(8); PG8_BAR; PG8_WAIT_L(0); PG8_MMA(0, 0, At, B0); PG8_BAR; PG8_SCHED;
            PG8_LDB(B1, 0, 1); PG8_STAGE(PG8_SB(0, 0), b2, voffB);
            PG8_BAR; PG8_WAIT_L(0); PG8_MMA(0, 1, At, B1); PG8_BAR;
            PG8_LDA(At, 0, 1); PG8_STAGE(PG8_SA(0, 0), a2, voffA);
            PG8_BAR; PG8_WAIT_L(0); PG8_MMA(1, 0, At, B0); PG8_BAR; PG8_SCHED;
            PG8_STAGE(PG8_SB(0, 1), b2 + hstep, voffB);
            PG8_WAIT_V(6); PG8_BAR; PG8_MMA(1, 1, At, B1); PG8_BAR;
            PG8_LDB(B0, 1, 0); PG8_SCHED; PG8_LDA(At, 1, 0); PG8_STAGE(PG8_SA(0, 1), a2 + hstep, voffA);
            PG8_WAIT_L(8); PG8_BAR; PG8_WAIT_L(0); PG8_MMA(0, 0, At, B0); PG8_BAR; PG8_SCHED;
            PG8_LDB(B1, 1, 1); PG8_STAGE(PG8_SB(1, 0), b3, voffB);
            PG8_BAR; PG8_WAIT_L(0); PG8_MMA(0, 1, At, B1); PG8_BAR;
            PG8_LDA(At, 1, 1); PG8_STAGE(PG8_SA(1, 0), a3, voffA);
            PG8_BAR; PG8_WAIT_L(0); PG8_MMA(1, 0, At, B0); PG8_BAR; PG8_SCHED;
            PG8_STAGE(PG8_SB(1, 1), b3 + hstep, voffB);
            PG8_WAIT_V(6); PG8_BAR; PG8_MMA(1, 1, At, B1); PG8_BAR;
            }
        }
        if constexpr (ALIGN_EPI) { if (wr == 0) PG8_BAR; }
        if constexpr (!Epi::AFTER_DRAIN) { E(acc, cur, wr, wc, fr, fq); S.done(cur); }
        if (!has_next) break;
#pragma unroll
        for (int a = 0; a < 2; ++a)
#pragma unroll
            for (int b = 0; b < 2; ++b)
#pragma unroll
                for (int m = 0; m < 4; ++m)
#pragma unroll
                    for (int n = 0; n < 2; ++n) acc[a][b][m][n] = (f32x4){0.f, 0.f, 0.f, 0.f};
        cur = nxt; cA = nA; cB = nB; ++ui;
        if constexpr (ALIGN_EPI) { if (wr == 1) PG8_BAR; }
    }
    PG8_WAIT_V(0);
    if constexpr (!ALIGN_EPI) { if (wr == 0) PG8_BAR; }
    PG8_BAR;
    if constexpr (Epi::AFTER_DRAIN) { E.fused(acc, cur, wr, wc, fr, fq, lds, wid, lane); S.done(cur); }
#undef PG8_SA
#undef PG8_SB
#undef PG8_STAGE
#undef PG8_LDA
#undef PG8_LDB
#undef PG8_MMA
#undef PG8_WAIT_V
#undef PG8_WAIT_L
#undef PG8_BAR
#undef PG8_SCHED
}
}

#define LAS __attribute__((address_space(3)))
using pg8::bf16_t; using pg8::bf16x8; using pg8::f32x4; using pg8::u32x4;
typedef float f32x16 __attribute__((ext_vector_type(16)));
typedef short s16x4 __attribute__((ext_vector_type(4)));
typedef unsigned u32x2 __attribute__((ext_vector_type(2)));
constexpr int MP = 32768, MS = 2048, M = MP + MS;
constexpr int D = 1024, FF = 2816, SEQ = 8192, DSEQ = 64, PAST = 1024;
constexpr float EPS = 1e-6f;
constexpr float C2 = 0.125f * 1.4426950408889634f;
constexpr size_t OKP = (size_t)M * D, OVP = OKP + (size_t)MP * D, OCP = OVP + (size_t)MP * D, OKS = OCP + 4 * 2 * D, OVS = OKS + (size_t)MS * D, OCS = OVS + (size_t)MS * D;
constexpr size_t MiB = 1u << 20;
constexpr size_t WS_SSQ = 0, WS_WGU1 = 1 * MiB, WS_WD1 = 12 * MiB, WS_WIN = 18 * MiB, WS_WAC = 34 * MiB, WS_WM = 38 * MiB, WS_WGU2 = 40 * MiB, WS_WD2 = 51 * MiB;
constexpr size_t WS_H = 60 * MiB, WS_HFF = 128 * MiB, WS_YRAW = 332 * MiB;
constexpr size_t WS_Q = 128 * MiB, WS_K = 196 * MiB, WS_V = 264 * MiB, WS_CB = 332 * MiB, WS_U = 400 * MiB, WS_END = 468 * MiB;
constexpr int LDS_BYTES = 163840;
constexpr size_t WS_BAR = 896 * 1024;
constexpr int LDS_MISC = 4 * 38912 + 256;

struct Params { const float* in[29]; float* out; unsigned char* ws; int nrep, pad; };

__device__ __forceinline__ unsigned pk2(float lo, float hi) { typedef float f2 __attribute__((ext_vector_type(2))); typedef __bf16 b2 __attribute__((ext_vector_type(2))); f2 v = {lo, hi}; b2 b = __builtin_convertvector(v, b2); return __builtin_bit_cast(unsigned, b); }
__device__ __forceinline__ float bf_lo(unsigned w) { return __uint_as_float(w << 16); }
__device__ __forceinline__ float bf_hi(unsigned w) { return __uint_as_float(w & 0xffff0000u); }
__device__ __forceinline__ u32x4 pack8(f32x4 a, f32x4 b) { u32x4 w; w.x = pk2(a[0], a[1]); w.y = pk2(a[2], a[3]); w.z = pk2(b[0], b[1]); w.w = pk2(b[2], b[3]); return w; }
__device__ __forceinline__ void unpack8(u32x4 w, f32x4& a, f32x4& b) { a = (f32x4){bf_lo(w.x), bf_hi(w.x), bf_lo(w.y), bf_hi(w.y)}; b = (f32x4){bf_lo(w.z), bf_hi(w.z), bf_lo(w.w), bf_hi(w.w)}; }
__device__ __forceinline__ float wave_sum(float v) {
#pragma unroll
    for (int o = 1; o < 64; o <<= 1) v += __shfl_xor(v, o);
    return v;
}
__device__ __forceinline__ float sigmoidf_fast(float x) { return __builtin_amdgcn_rcpf(1.f + __builtin_amdgcn_exp2f(-1.4426950409f * x)); }

struct EpiSwiGLU {
    static constexpr bool PERM = true, AFTER_DRAIN = false;
    bf16_t* O; const float* ssqx;
    __device__ __forceinline__ void operator()(const f32x4 (&acc)[2][2][4][2], const pg8::Unit& u, int wr, int wc, int fr, int fq) const {
        const int row0 = u.pm * 256 + wr * 64 + fr, col0 = u.pn * 128 + wc * 32 + 8 * fq;
#pragma unroll
        for (int ai = 0; ai < 2; ++ai)
#pragma unroll
            for (int m = 0; m < 4; ++m) {
                f32x4 v[2]; const float rs = rsqrtf(ssqx[row0 + ai * 128 + m * 16] * (1.f / D) + EPS);
#pragma unroll
                for (int n = 0; n < 2; ++n)
#pragma unroll
                    for (int i = 0; i < 4; ++i) { const float g = acc[ai][0][m][n][i] * rs; v[n][i] = g * sigmoidf_fast(g) * (acc[ai][1][m][n][i] * rs); }
                *(u32x4*)(O + (size_t)(row0 + ai * 128 + m * 16) * FF + col0) = pack8(v[0], v[1]);
            }
    }
};
struct EpiYSsq {
    static constexpr bool PERM = true, AFTER_DRAIN = false;
    bf16_t* Y; float* ssq;
    __device__ __forceinline__ void operator()(const f32x4 (&acc)[2][2][4][2], const pg8::Unit& u, int wr, int wc, int fr, int fq) const {
        const int row0 = u.pm * 256 + wr * 64 + fr, col0 = u.pn * 256 + wc * 32 + 8 * fq;
#pragma unroll
        for (int ai = 0; ai < 2; ++ai)
#pragma unroll
            for (int m = 0; m < 4; ++m) {
                const int row = row0 + ai * 128 + m * 16; float s = 0.f;
#pragma unroll
                for (int bj = 0; bj < 2; ++bj) { const f32x4 a = acc[ai][bj][m][0], b = acc[ai][bj][m][1];
                    s += (a[0] * a[0] + a[1] * a[1]) + (a[2] * a[2] + a[3] * a[3]) + (b[0] * b[0] + b[1] * b[1]) + (b[2] * b[2] + b[3] * b[3]);
                    *(u32x4*)(Y + (size_t)row * D + col0 + bj * 128) = pack8(a, b); }
                s += __shfl_xor(s, 16); s += __shfl_xor(s, 32);
                if (fq == 0) unsafeAtomicAdd(ssq + row, s);
            }
    }
};
struct EpiWin {
    static constexpr bool PERM = true, AFTER_DRAIN = false;
    bf16_t *Q, *Kb, *Vb, *CB, *U, *GA, *GB; float* out; const float* bgate; int pn_off; const float* ssqx;
    __device__ __forceinline__ void operator()(const f32x4 (&acc)[2][2][4][2], const pg8::Unit& u, int wr, int wc, int fr, int fq) const {
        const int pn = u.pn + pn_off, row0 = u.pm * 256 + wr * 64 + fr, cw = wc * 32 + 8 * fq;
        float rsv[2][4];
#pragma unroll
        for (int ai = 0; ai < 2; ++ai)
#pragma unroll
            for (int m = 0; m < 4; ++m) rsv[ai][m] = rsqrtf(ssqx[row0 + ai * 128 + m * 16] * (1.f / D) + EPS);
        if (pn < 4) {
#pragma unroll
            for (int ai = 0; ai < 2; ++ai)
#pragma unroll
                for (int m = 0; m < 4; ++m)
#pragma unroll
                    for (int bj = 0; bj < 2; ++bj)
                        *(u32x4*)(Q + (size_t)(row0 + ai * 128 + m * 16) * D + pn * 256 + bj * 128 + cw) = pack8(acc[ai][bj][m][0] * (C2 * rsv[ai][m]), acc[ai][bj][m][1] * (C2 * rsv[ai][m]));
        } else if (pn < 12) {
            const bool isv = pn >= 8; const int cb = (pn - (isv ? 8 : 4)) * 256 + cw;
            bf16_t* bd = isv ? Vb : Kb;
            float* od = (u.pm < MP / 256) ? out + (isv ? OVP : OKP) : out + (isv ? OVS : OKS) - (size_t)MP * D;
#pragma unroll
            for (int ai = 0; ai < 2; ++ai)
#pragma unroll
                for (int m = 0; m < 4; ++m)
#pragma unroll
                    for (int bj = 0; bj < 2; ++bj) { const size_t off = (size_t)(row0 + ai * 128 + m * 16) * D + cb + bj * 128;
                        const f32x4 a = acc[ai][bj][m][0] * rsv[ai][m], b = acc[ai][bj][m][1] * rsv[ai][m];
                        *(u32x4*)(bd + off) = pack8(a, b);
                        *(f32x4*)(od + off) = a; *(f32x4*)(od + off + 4) = b; }
        } else if (pn < 16) {
#pragma unroll
            for (int ai = 0; ai < 2; ++ai)
#pragma unroll
                for (int m = 0; m < 4; ++m)
#pragma unroll
                    for (int bj = 0; bj < 2; ++bj)
                        *(u32x4*)(CB + (size_t)(row0 + ai * 128 + m * 16) * D + (pn - 12) * 256 + bj * 128 + cw) = pack8(acc[ai][bj][m][0] * rsv[ai][m], acc[ai][bj][m][1] * rsv[ai][m]);
        } else if (pn < 24) {
#pragma unroll
            for (int ai = 0; ai < 2; ++ai)
#pragma unroll
                for (int m = 0; m < 4; ++m)
                    *(u32x4*)(U + (size_t)(row0 + ai * 128 + m * 16) * D + (pn - 16) * 128 + cw) = pack8(acc[ai][0][m][0] * acc[ai][1][m][0] * (rsv[ai][m] * rsv[ai][m]), acc[ai][0][m][1] * acc[ai][1][m][1] * (rsv[ai][m] * rsv[ai][m]));
        } else {
            const bool isb = pn >= 28; const int cb = (pn - (isb ? 28 : 24)) * 256 + cw;
            bf16_t* gd = isb ? GB : GA; const float* bias = bgate + (isb ? D : 0) + cb;
#pragma unroll
            for (int bj = 0; bj < 2; ++bj) { const f32x4 b0 = *(const f32x4*)(bias + bj * 128), b1 = *(const f32x4*)(bias + bj * 128 + 4);
#pragma unroll
                for (int ai = 0; ai < 2; ++ai)
#pragma unroll
                    for (int m = 0; m < 4; ++m) { f32x4 a = acc[ai][bj][m][0] * rsv[ai][m] + b0, b = acc[ai][bj][m][1] * rsv[ai][m] + b1;
#pragma unroll
                        for (int i = 0; i < 4; ++i) { a[i] = sigmoidf_fast(a[i]); b[i] = sigmoidf_fast(b[i]); }
                        *(u32x4*)(gd + (size_t)(row0 + ai * 128 + m * 16) * D + cb + bj * 128) = pack8(a, b); } }
        }
    }
};
struct EpiMerge {
    static constexpr bool PERM = true, AFTER_DRAIN = false;
    const bf16_t *GA, *GB; bf16_t* MRG;
    __device__ __forceinline__ void operator()(const f32x4 (&acc)[2][2][4][2], const pg8::Unit& u, int wr, int wc, int fr, int fq) const {
        const bool second = u.pn >= 4; const int row0 = u.pm * 256 + wr * 64 + fr, col0 = (u.pn & 3) * 256 + wc * 32 + 8 * fq;
        const bf16_t* G = second ? GB : GA;
#pragma unroll
        for (int ai = 0; ai < 2; ++ai)
#pragma unroll
            for (int m = 0; m < 4; ++m)
#pragma unroll
                for (int bj = 0; bj < 2; ++bj) { const size_t off = (size_t)(row0 + ai * 128 + m * 16) * D + col0 + bj * 128;
                    f32x4 g0, g1; unpack8(*(const u32x4*)(G + off), g0, g1);
                    f32x4 a = acc[ai][bj][m][0] * g0, b = acc[ai][bj][m][1] * g1;
                    if (second) { f32x4 p0, p1; unpack8(*(const u32x4*)(MRG + off), p0, p1); a += p0; b += p1; }
                    *(u32x4*)(MRG + off) = pack8(a, b); }
    }
};
struct PairOrder {
    int G, c, pm0, nL;
    __device__ bool next(int i, pg8::Unit& u) const { const int L = (i >> 1) * G + c; if (L >= nL) return false; u.pm = pm0 + (L >> 2); u.pn = (L & 3) + 4 * (i & 1); return true; }
    __device__ __forceinline__ void a_ready(const pg8::Unit&) const {}
    __device__ __forceinline__ void done(const pg8::Unit&) const {}
};
struct RangeOrder {
    pg8::StaticOrder S; int pm0;
    __device__ void init(int pm0_, int nM, int N, int G, int c) { S.init(nM * 256, N, G, c); pm0 = pm0_; }
    __device__ bool next(int i, pg8::Unit& u) const { if (!S.next(i, u)) return false; u.pm += pm0; return true; }
    __device__ __forceinline__ void a_ready(const pg8::Unit&) const {}
    __device__ __forceinline__ void done(const pg8::Unit&) const {}
};
struct SkipOrder {
    int G, c, ns, nL;
    __device__ bool next(int i, pg8::Unit& u) const {
        int L;
        if (G == 256 && nL == 512) { if (i == 0) L = c; else if (i == 1) { if (c < ns) return false; L = 256 + (c - ns); } else if (i == 2) { if (c < ns || c >= 2 * ns) return false; L = 512 - ns + (c - ns); } else return false; }
        else { L = i * G + c; if (L >= nL) return false; }
        u.pm = L >> 2; u.pn = L & 3; return true;
    }
    __device__ __forceinline__ void a_ready(const pg8::Unit&) const {}
    __device__ __forceinline__ void done(const pg8::Unit&) const {}
};

__device__ __forceinline__ void tr_item(const float* W, int ldw, int K, int ncols, bf16_t* WT, int mode, int row_off, const float* gk, LAS float* scr, int item, int lane) {
    const int nblk = ncols / 32, kb = item / nblk, nb = item % nblk, k0 = 64 * kb, n0 = 32 * nb;
#pragma unroll 8
    for (int i = 0; i < 32; ++i) { const int kk = 2 * i + (lane >> 5); scr[kk * 33 + (lane & 31)] = W[(size_t)(k0 + kk) * ldw + n0 + (lane & 31)] * (gk ? gk[k0 + kk] : 1.f); }
    asm volatile("s_waitcnt lgkmcnt(0)" ::: "memory");
    const int c = lane & 7, drow0 = row_off + (mode ? 256 * (n0 >> 7) + (n0 & 127) : n0);
#pragma unroll
    for (int j = 0; j < 4; ++j) { const int n = (lane >> 3) + 8 * j; const LAS float* s = scr + (8 * c) * 33 + n;
        u32x4 o; o.x = pk2(s[0 * 33], s[1 * 33]); o.y = pk2(s[2 * 33], s[3 * 33]); o.z = pk2(s[4 * 33], s[5 * 33]); o.w = pk2(s[6 * 33], s[7 * 33]);
        *(u32x4*)(WT + (size_t)(drow0 + n) * K + k0 + 8 * c) = o; }
    asm volatile("s_waitcnt lgkmcnt(0)" ::: "memory");
}
__device__ __forceinline__ const float* xrow_in(const Params& P, int r) { return r < MP ? P.in[0] + (size_t)r * D : P.in[1] + (size_t)(r - MP) * D; }

__device__ __forceinline__ void x0_rows(const Params& P, bf16_t* XB, float* ssqx, int gw, int NGW, int lane) {
    for (int r = gw; r < M; r += NGW) {
        const f32x4* xr = (const f32x4*)xrow_in(P, r); f32x4 v[4]; float s = 0.f;
#pragma unroll
        for (int j = 0; j < 4; ++j) { v[j] = xr[lane + 64 * j]; s += (v[j][0] * v[j][0] + v[j][1] * v[j][1]) + (v[j][2] * v[j][2] + v[j][3] * v[j][3]); }
        const float tot = wave_sum(s);
#pragma unroll
        for (int j = 0; j < 4; ++j) *(u32x2*)(XB + (size_t)r * D + (lane + 64 * j) * 4) = (u32x2){pk2(v[j][0], v[j][1]), pk2(v[j][2], v[j][3])};
        if (lane == 0) ssqx[r] = tot;
    }
}
template <bool FIRST, bool LAST>
__device__ __forceinline__ void ew_rows(const Params& P, const bf16_t* Y, const float* ssq, const float* gpost, float scale, bf16_t* XB, float* ssqx_out, int r_lo, int r_hi, int gw, int NGW, int lane) {
    for (int r = r_lo + gw; r < r_hi; r += NGW) {
        const float rs = rsqrtf(ssq[r] * (1.f / D) + EPS) * scale; float s = 0.f;
#pragma unroll
        for (int j = 0; j < 4; ++j) { const u32x2 yw = *(const u32x2*)(Y + (size_t)r * D + (lane + 64 * j) * 4); const f32x4 y = {bf_lo(yw.x), bf_hi(yw.x), bf_lo(yw.y), bf_hi(yw.y)};
            f32x4 xin;
            if (FIRST) xin = ((const f32x4*)xrow_in(P, r))[lane + 64 * j];
            else { const u32x2 xw = *(const u32x2*)(XB + (size_t)r * D + (lane + 64 * j) * 4); xin = (f32x4){bf_lo(xw.x), bf_hi(xw.x), bf_lo(xw.y), bf_hi(xw.y)}; }
            const f32x4 v = xin + y * rs * ((const f32x4*)gpost)[lane + 64 * j];
            if (LAST) ((f32x4*)(P.out + (size_t)r * D))[lane + 64 * j] = v;
            else { *(u32x2*)(XB + (size_t)r * D + (lane + 64 * j) * 4) = (u32x2){pk2(v[0], v[1]), pk2(v[2], v[3])}; s += (v[0] * v[0] + v[1] * v[1]) + (v[2] * v[2] + v[3] * v[3]); } }
        if (!LAST) { const float tot = wave_sum(s); if (lane == 0) ssqx_out[r] = tot; }
    }
}
__device__ __forceinline__ void conv_rows(const Params& P, bf16_t* CB, const bf16_t* U, int r_lo, int r_hi, int gw, int NGW, int lane) {
    const float* cw = P.in[20]; const float* cbias = P.in[21]; const float* st = P.in[4];
    for (int r = r_lo + gw; r < r_hi; r += NGW) {
        const bool samp = r >= MP; const int b = samp ? (r - MP) >> 6 : r >> 13, t = samp ? (r - MP) & 63 : r & 8191, T = samp ? DSEQ : SEQ;
#pragma unroll
        for (int jj = 0; jj < 2; ++jj) { const int c = (lane + 64 * jj) * 8;
            f32x4 u0a, u0b, u1a, u1b, u2a, u2b, ca, cb2; const f32x4 z4 = {0.f, 0.f, 0.f, 0.f};
            unpack8(*(const u32x4*)(U + (size_t)r * D + c), u0a, u0b);
            if (t >= 1) unpack8(*(const u32x4*)(U + (size_t)(r - 1) * D + c), u1a, u1b);
            else if (samp) { u1a = *(const f32x4*)(st + ((size_t)b * 2 + 1) * D + c); u1b = *(const f32x4*)(st + ((size_t)b * 2 + 1) * D + c + 4); } else { u1a = z4; u1b = z4; }
            if (t >= 2) unpack8(*(const u32x4*)(U + (size_t)(r - 2) * D + c), u2a, u2b);
            else if (samp) { u2a = *(const f32x4*)(st + ((size_t)b * 2 + t) * D + c); u2b = *(const f32x4*)(st + ((size_t)b * 2 + t) * D + c + 4); } else { u2a = z4; u2b = z4; }
            unpack8(*(const u32x4*)(CB + (size_t)r * D + c), ca, cb2);
            const f32x4 w0a = *(const f32x4*)(cw + c), w0b = *(const f32x4*)(cw + c + 4), w1a = *(const f32x4*)(cw + D + c), w1b = *(const f32x4*)(cw + D + c + 4), w2a = *(const f32x4*)(cw + 2 * D + c), w2b = *(const f32x4*)(cw + 2 * D + c + 4);
            const f32x4 ba = *(const f32x4*)(cbias + c), bb = *(const f32x4*)(cbias + c + 4);
            const f32x4 za = ba + w0a * u2a + w1a * u1a + w2a * u0a, zb = bb + w0b * u2b + w1b * u1b + w2b * u0b;
            *(u32x4*)(CB + (size_t)r * D + c) = pack8(ca * za, cb2 * zb);
            if (t >= T - 2) { float* o = P.out + (samp ? OCS : OCP) + ((size_t)b * 2 + (t - (T - 2))) * D + c; *(f32x4*)o = u0a; *(f32x4*)(o + 4) = u0b; }
        }
    }
}

constexpr int KROW = 144, VROW = 320, KBUF = 64 * KROW, STAGE = 2 * KBUF + 64 * VROW;
typedef short v4i16_t __attribute__((ext_vector_type(4)));
__device__ __forceinline__ s16x4 vtr(const LAS unsigned char* p) { return __builtin_bit_cast(s16x4, __builtin_amdgcn_ds_read_tr16_b64_v4i16((LAS v4i16_t*)p)); }
#define MFMA32(a, b, c) __builtin_amdgcn_mfma_f32_32x32x16_bf16((a), (b), (c), 0, 0, 0)
__device__ __forceinline__ void glds16(const void* gsrc, unsigned lds_dst) { unsigned keep;
    asm volatile("s_mov_b32 %0, m0\n\ts_mov_b32 m0, %2\n\ts_nop 0\n\tglobal_load_lds_dwordx4 %1, off\n\ts_mov_b32 m0, %0" : "=&s"(keep) : "v"(gsrc), "s"(lds_dst) : "memory"); }
__device__ __forceinline__ bf16x8 packp(const f32x16& p, int b) { u32x4 w; w.x = pk2(p[b], p[b + 1]); w.y = pk2(p[b + 2], p[b + 3]); w.z = pk2(p[b + 4], p[b + 5]); w.w = pk2(p[b + 6], p[b + 7]); return __builtin_bit_cast(bf16x8, w); }
#define SBAR() __builtin_amdgcn_sched_barrier(0)
__device__ __forceinline__ void attn_tile(const LAS unsigned char* st, int map, int lane, const bf16x8 (&qf)[4], f32x16 (&o)[4], f32x16& lsum, float& m_run, bool first) {
    const int r32 = lane & 31, hh = lane >> 5;
    const LAS unsigned char* kp = st + map * KBUF + r32 * KROW + hh * 16;
    const LAS unsigned char* vp = st + 2 * KBUF + (4 * hh + ((lane & 15) >> 2)) * VROW + 32 * ((lane >> 4) & 1) + 8 * (lane & 3);
    f32x16 p0, p1;
    { const float nm = -m_run;
#pragma unroll
      for (int i = 0; i < 16; ++i) { p0[i] = nm; p1[i] = nm; } }
    bf16x8 kf[8]; s16x4 vlo[2][4], vhi[2][4];
    SBAR();
#pragma unroll
    for (int ds = 0; ds < 4; ++ds) { kf[2 * ds] = *(const LAS bf16x8*)(kp + ds * 32); kf[2 * ds + 1] = *(const LAS bf16x8*)(kp + 32 * KROW + ds * 32); }
#pragma unroll
    for (int d = 0; d < 4; ++d) { vlo[0][d] = vtr(vp + d * 64); vhi[0][d] = vtr(vp + 8 * VROW + d * 64); }
    SBAR();
#pragma unroll
    for (int ds = 0; ds < 4; ++ds) { p0 = MFMA32(kf[2 * ds], qf[ds], p0); p1 = MFMA32(kf[2 * ds + 1], qf[ds], p1); }
    SBAR();
    f32x16 e0, e1;
#pragma unroll
    for (int i = 0; i < 16; ++i) { e0[i] = __builtin_amdgcn_exp2f(p0[i]); e1[i] = __builtin_amdgcn_exp2f(p1[i]); }
    float mt = fmaxf(fmaxf(e0[0], e1[0]), e0[1]);
#pragma unroll
    for (int i = 1; i < 16; ++i) mt = (i == 1) ? fmaxf(mt, e1[1]) : fmaxf(fmaxf(mt, e0[i]), e1[i]);
    { auto rr = __builtin_amdgcn_permlane32_swap(__float_as_uint(mt), __float_as_uint(mt), false, false); mt = fmaxf(__uint_as_float(rr[0]), __uint_as_float(rr[1])); }
    if (first || __any(!(mt <= 256.f))) {
        float rm = fmaxf(p0[0], p1[0]);
#pragma unroll
        for (int i = 1; i < 16; ++i) rm = fmaxf(rm, fmaxf(p0[i], p1[i]));
        { auto rr = __builtin_amdgcn_permlane32_swap(__float_as_uint(rm), __float_as_uint(rm), false, false); rm = fmaxf(__uint_as_float(rr[0]), __uint_as_float(rr[1])); }
        const float dl = first ? rm : fmaxf(rm, 0.f);
        m_run += dl;
#pragma unroll
        for (int i = 0; i < 16; ++i) { e0[i] = __builtin_amdgcn_exp2f(p0[i] - dl); e1[i] = __builtin_amdgcn_exp2f(p1[i] - dl); }
        if (!first) { const float a = __builtin_amdgcn_exp2f(-dl);
#pragma unroll
            for (int i = 0; i < 16; ++i) lsum[i] *= a;
#pragma unroll
            for (int d = 0; d < 4; ++d)
#pragma unroll
                for (int i = 0; i < 16; ++i) o[d][i] *= a; }
    }
    bf16x8 pf[4]; pf[0] = packp(e0, 0); pf[1] = packp(e0, 8); pf[2] = packp(e1, 0); pf[3] = packp(e1, 8);
    const bf16x8 ones = {(short)0x3F80, (short)0x3F80, (short)0x3F80, (short)0x3F80, (short)0x3F80, (short)0x3F80, (short)0x3F80, (short)0x3F80};
    SBAR();
#pragma unroll
    for (int ks = 0; ks < 4; ++ks) {
        if (ks < 3) {
#pragma unroll
            for (int d = 0; d < 4; ++d) { vlo[(ks + 1) & 1][d] = vtr(vp + (ks + 1) * 16 * VROW + d * 64); vhi[(ks + 1) & 1][d] = vtr(vp + (ks + 1) * 16 * VROW + 8 * VROW + d * 64); }
            SBAR();
        }
#pragma unroll
        for (int d = 0; d < 4; ++d) { const bf16x8 a = __builtin_shufflevector(vlo[ks & 1][d], vhi[ks & 1][d], 0, 1, 2, 3, 4, 5, 6, 7); o[d] = MFMA32(a, pf[ks], o[d]); }
        lsum = MFMA32(ones, pf[ks], lsum);
        SBAR();
    }
}
template <bool PACK>
__device__ __forceinline__ void attn_qk(const LAS unsigned char* st, int map, int lane, const bf16x8 (&qf)[4], float m_run, f32x16& p0, f32x16& p1, const f32x16& e0, const f32x16& e1, bf16x8 (&pf)[4]) {
    const int r32 = lane & 31, hh = lane >> 5;
    const LAS unsigned char* kp = st + map * KBUF + r32 * KROW + hh * 16;
    { const float nm = -m_run;
#pragma unroll
      for (int i = 0; i < 16; ++i) { p0[i] = nm; p1[i] = nm; } }
    bf16x8 kf[8]; u32x4 pw[4];
    SBAR();
#pragma unroll
    for (int ds = 0; ds < 4; ++ds) { kf[2 * ds] = *(const LAS bf16x8*)(kp + ds * 32); kf[2 * ds + 1] = *(const LAS bf16x8*)(kp + 32 * KROW + ds * 32); }
    SBAR();
#pragma unroll
    for (int k = 0; k < 8; ++k) {
        if (k & 1) p1 = MFMA32(kf[k], qf[k >> 1], p1); else p0 = MFMA32(kf[k], qf[k >> 1], p0);
        if (PACK) {
#pragma unroll
            for (int w = 2 * k; w < 2 * k + 2; ++w) pw[w >> 2][w & 3] = (w < 8) ? pk2(e0[2 * w], e0[2 * w + 1]) : pk2(e1[2 * (w - 8)], e1[2 * (w - 8) + 1]);
        }
        SBAR();
    }
    if (PACK) {
#pragma unroll
        for (int j = 0; j < 4; ++j) pf[j] = __builtin_bit_cast(bf16x8, pw[j]);
    }
}
template <bool PV>
__device__ __forceinline__ void attn_exp_pv(const LAS unsigned char* stv, int lane, const bf16x8 (&pf)[4], f32x16 (&o)[4], f32x16& lsum, const f32x16& p0, const f32x16& p1, f32x16& e0, f32x16& e1, float& mt) {
    const int hh = lane >> 5;
    const LAS unsigned char* vp = stv + 2 * KBUF + (4 * hh + ((lane & 15) >> 2)) * VROW + 32 * ((lane >> 4) & 1) + 8 * (lane & 3);
    const bf16x8 ones = {(short)0x3F80, (short)0x3F80, (short)0x3F80, (short)0x3F80, (short)0x3F80, (short)0x3F80, (short)0x3F80, (short)0x3F80};
    SBAR();
    if (PV) {
        s16x4 vlo[2][4], vhi[2][4];
#pragma unroll
        for (int d = 0; d < 4; ++d) { vlo[0][d] = vtr(vp + d * 64); vhi[0][d] = vtr(vp + 8 * VROW + d * 64); }
        SBAR();
#pragma unroll
        for (int ks = 0; ks < 4; ++ks) {
            if (ks < 3) {
#pragma unroll
                for (int d = 0; d < 4; ++d) { vlo[(ks + 1) & 1][d] = vtr(vp + (ks + 1) * 16 * VROW + d * 64); vhi[(ks + 1) & 1][d] = vtr(vp + (ks + 1) * 16 * VROW + 8 * VROW + d * 64); }
                SBAR();
            }
#pragma unroll
            for (int d = 0; d < 5; ++d) {
                if (d < 4) { const bf16x8 a = __builtin_shufflevector(vlo[ks & 1][d], vhi[ks & 1][d], 0, 1, 2, 3, 4, 5, 6, 7); o[d] = MFMA32(a, pf[ks], o[d]); }
                else lsum = MFMA32(ones, pf[ks], lsum);
                const int g = ks * 5 + d;
                if (g < 16) { e0[g] = __builtin_amdgcn_exp2f(p0[g]); e1[g] = __builtin_amdgcn_exp2f(p1[g]); }
                SBAR();
            }
        }
    } else {
#pragma unroll
        for (int i = 0; i < 16; ++i) { e0[i] = __builtin_amdgcn_exp2f(p0[i]); e1[i] = __builtin_amdgcn_exp2f(p1[i]); }
    }
    mt = fmaxf(fmaxf(e0[0], e1[0]), e0[1]);
#pragma unroll
    for (int i = 1; i < 16; ++i) mt = (i == 1) ? fmaxf(mt, e1[1]) : fmaxf(fmaxf(mt, e0[i]), e1[i]);
    SBAR();
}
__device__ __forceinline__ void attn_decide_pack(const f32x16& p0, const f32x16& p1, f32x16& e0, f32x16& e1, float mt, f32x16 (&o)[4], f32x16& lsum, float& m_run, bool first, bf16x8 (&pf)[4]) {
    { auto rr = __builtin_amdgcn_permlane32_swap(__float_as_uint(mt), __float_as_uint(mt), false, false); mt = fmaxf(__uint_as_float(rr[0]), __uint_as_float(rr[1])); }
    if (first || __any(!(mt <= 256.f))) {
        float rm = fmaxf(p0[0], p1[0]);
#pragma unroll
        for (int i = 1; i < 16; ++i) rm = fmaxf(rm, fmaxf(p0[i], p1[i]));
        { auto rr = __builtin_amdgcn_permlane32_swap(__float_as_uint(rm), __float_as_uint(rm), false, false); rm = fmaxf(__uint_as_float(rr[0]), __uint_as_float(rr[1])); }
        const float dl = first ? rm : fmaxf(rm, 0.f);
        m_run += dl;
#pragma unroll
        for (int i = 0; i < 16; ++i) { e0[i] = __builtin_amdgcn_exp2f(p0[i] - dl); e1[i] = __builtin_amdgcn_exp2f(p1[i] - dl); }
        if (!first) { const float a = __builtin_amdgcn_exp2f(-dl);
#pragma unroll
            for (int i = 0; i < 16; ++i) lsum[i] *= a;
#pragma unroll
            for (int d = 0; d < 4; ++d)
#pragma unroll
                for (int i = 0; i < 16; ++i) o[d][i] *= a; }
    }
}
template <bool SAMPLE>
__device__ __forceinline__ void attn_unit(LAS unsigned char* L, const bf16_t* Qb, const bf16_t* Kb, const bf16_t* Vb, bf16_t* Ob, const float* cK, const float* cV,
                                          size_t qrow0, size_t kvrow0, int head, int NT, float lam, const float* subg, bool do_store) {
    int tid_l = threadIdx.x; asm volatile("" : "+v"(tid_l));
    const int tid = tid_l, lane = tid & 63, r32 = lane & 31, hh = lane >> 5;
    const int wid = __builtin_amdgcn_readfirstlane(tid >> 6), map = wid >> 2, qg = wid & 3;
    const bool active = SAMPLE ? (qg < 2) : true;
    const int nvis = SAMPLE ? NT : ((qg < 2) ? NT - 1 : NT);
    bf16x8 qf[4];
    { const bf16_t* qp = Qb + (qrow0 + (active ? qg * 32 + r32 : 0)) * D + head * 128 + map * 64 + hh * 8;
#pragma unroll
      for (int ds = 0; ds < 4; ++ds) qf[ds] = *(const bf16x8*)(qp + ds * 16); }
    asm volatile("" : "+v"(qf[0]), "+v"(qf[1]), "+v"(qf[2]), "+v"(qf[3]));
    f32x16 o[4];
#pragma unroll
    for (int d = 0; d < 4; ++d)
#pragma unroll
        for (int i = 0; i < 16; ++i) o[d][i] = 0.f;
    float m_run = 0.f; f32x16 lsum;
#pragma unroll
    for (int i = 0; i < 16; ++i) lsum[i] = 0.f;
    const int skey = tid >> 4, sch = tid & 15;
    const size_t gofs = (size_t)skey * D + head * 128 + sch * 8;
    const int dK = (sch >> 3) * KBUF + skey * KROW + (sch & 7) * 16, dV = 2 * KBUF + skey * VROW + sch * 16;
    if (!SAMPLE) {
        const bf16_t* src[5]; unsigned dsto[5];
#pragma unroll
        for (int j = 0; j < 5; ++j) { int p = wid + 8 * j; if (p > 37) p -= 2; const int c = 64 * p + lane; dsto[j] = (unsigned)p * 1024u;
            if (p < 18) { const int mp = c / 576, rc = c - mp * 576, row = rc / 9; int col = rc - row * 9; if (col == 8) col = 0; src[j] = Kb + (kvrow0 + row) * D + head * 128 + mp * 64 + col * 8; }
            else { const int c2 = c - 1152, row = c2 / 20, col = (c2 - row * 20) & 15; src[j] = Vb + (kvrow0 + row) * D + head * 128 + col * 8; } }
        const unsigned lds0 = (unsigned)(uintptr_t)L;
#define AT_DMA(t, sb) do { _Pragma("unroll") for (int j_ = 0; j_ < 5; ++j_) glds16(src[j_] + (size_t)(t) * 64 * D, (unsigned)__builtin_amdgcn_readfirstlane(lds0 + (sb) + dsto[j_])); } while (0)
        bf16x8 pf[4]; f32x16 p0, p1, e0, e1; float mt;
        AT_DMA(0, 0); AT_DMA(1, STAGE);
        asm volatile("s_waitcnt vmcnt(5) lgkmcnt(0)\n\ts_barrier" ::: "memory");
        for (int t = 0; t < NT; ++t) {
            if (t + 2 < NT) AT_DMA(t + 2, ((t + 2) & 3) * STAGE);
            if (t < nvis) {
                if (t == 0) { attn_qk<false>(L, map, lane, qf, m_run, p0, p1, e0, e1, pf); attn_exp_pv<false>(L, lane, pf, o, lsum, p0, p1, e0, e1, mt); }
                else { attn_qk<true>(L + (t & 3) * STAGE, map, lane, qf, m_run, p0, p1, e0, e1, pf); attn_exp_pv<true>(L + ((t - 1) & 3) * STAGE, lane, pf, o, lsum, p0, p1, e0, e1, mt); }
                attn_decide_pack(p0, p1, e0, e1, mt, o, lsum, m_run, t == 0, pf);
            }
            if (t + 2 < NT) asm volatile("s_waitcnt vmcnt(5) lgkmcnt(0)\n\ts_barrier" ::: "memory");
            else asm volatile("s_waitcnt vmcnt(0) lgkmcnt(0)\n\ts_barrier" ::: "memory");
        }
        { pf[0] = packp(e0, 0); pf[1] = packp(e0, 8); pf[2] = packp(e1, 0); pf[3] = packp(e1, 8);
          f32x16 z0 = p0, z1 = p1; float mt2;
          attn_exp_pv<true>(L + ((nvis - 1) & 3) * STAGE, lane, pf, o, lsum, z0, z1, e0, e1, mt2); }
        __syncthreads();
    } else {
        const int key = tid >> 5, f4 = tid & 31;
        f32x4 fk[4], fv[4];
#define AT_LOADF(t) do { _Pragma("unroll") for (int i_ = 0; i_ < 4; ++i_) { const size_t src_ = ((size_t)((t) * 64 + key + 16 * i_) * 8 + head) * 128 + f4 * 4; fk[i_] = *(const f32x4*)(cK + src_); fv[i_] = *(const f32x4*)(cV + src_); } } while (0)
        AT_LOADF(0);
        for (int t = 0; t < NT; ++t) {
            LAS unsigned char* s_ = L + (t & 1) * STAGE;
            if (t < PAST / 64) {
#pragma unroll
                for (int i = 0; i < 4; ++i) {
                    *(LAS u32x2*)(s_ + (f4 >> 4) * KBUF + (key + 16 * i) * KROW + (f4 & 15) * 8) = (u32x2){pk2(fk[i][0], fk[i][1]), pk2(fk[i][2], fk[i][3])};
                    *(LAS u32x2*)(s_ + 2 * KBUF + (key + 16 * i) * VROW + f4 * 8) = (u32x2){pk2(fv[i][0], fv[i][1]), pk2(fv[i][2], fv[i][3])}; }
            } else {
                u32x4 rk0, rk1, rv0, rv1;
                { const bf16_t* kp_ = Kb + qrow0 * D + gofs; const bf16_t* vp_ = Vb + qrow0 * D + gofs;
                  rk0 = *(const u32x4*)kp_; rk1 = *(const u32x4*)(kp_ + 32 * D); rv0 = *(const u32x4*)vp_; rv1 = *(const u32x4*)(vp_ + 32 * D); }
                *(LAS u32x4*)(s_ + dK) = rk0; *(LAS u32x4*)(s_ + dK + 32 * KROW) = rk1; *(LAS u32x4*)(s_ + dV) = rv0; *(LAS u32x4*)(s_ + dV + 32 * VROW) = rv1;
            }
            __syncthreads();
            if (t + 1 < PAST / 64) AT_LOADF(t + 1);
            if (active) attn_tile(s_, map, lane, qf, o, lsum, m_run, t == 0);
        }
        __syncthreads();
    }
    const float inv = active ? 1.f / lsum[0] : 0.f;
    LAS float* X = (LAS float*)L;
    if (active && map == 1) {
#pragma unroll
        for (int d = 0; d < 4; ++d)
#pragma unroll
            for (int i = 0; i < 16; ++i) X[((qg * 4 + d) * 16 + i) * 64 + lane] = o[d][i] * inv;
    }
    __syncthreads();
    if (active && map == 0 && do_store) {
        float ss = 0.f;
#pragma unroll
        for (int d = 0; d < 4; ++d)
#pragma unroll
            for (int i = 0; i < 16; ++i) { const float v = o[d][i] * inv - lam * X[((qg * 4 + d) * 16 + i) * 64 + lane]; o[d][i] = v; ss += v * v; }
        ss += __shfl_xor(ss, 32);
        const float rs = rsqrtf(ss * (1.f / 128.f) + EPS) * 0.8f;
        bf16_t* op = Ob + (qrow0 + qg * 32 + r32) * D + head * 128 + 4 * hh;
#pragma unroll
        for (int d = 0; d < 4; ++d)
#pragma unroll
            for (int g4 = 0; g4 < 4; ++g4) { const f32x4 gg = *(const f32x4*)(subg + 32 * d + 8 * g4 + 4 * hh);
                *(u32x2*)(op + 32 * d + 8 * g4) = (u32x2){pk2(o[d][4 * g4] * rs * gg[0], o[d][4 * g4 + 1] * rs * gg[1]), pk2(o[d][4 * g4 + 2] * rs * gg[2], o[d][4 * g4 + 3] * rs * gg[3])}; }
    }
    __syncthreads();
}

#define XB_TMO      128
#define XB_XCNT(j)  (256  + 64 * (j))
#define XB_XSUB(j)  (1280 + 64 * (j))
#define XB_XGEN(j)  (2304 + 64 * (j))
#define XB_TOP      3328
#define XB_TOPGEN   3392
#define XCD_BAR_WORDS 3456
#define XB_SPIN_CAP (1u << 18)

__device__ __forceinline__ unsigned xb_ld(unsigned* p)              { return __hip_atomic_load(p, __ATOMIC_RELAXED, __HIP_MEMORY_SCOPE_AGENT); }
__device__ __forceinline__ unsigned xb_add(unsigned* p, unsigned v) { return __hip_atomic_fetch_add(p, v, __ATOMIC_RELAXED, __HIP_MEMORY_SCOPE_AGENT); }
__device__ __forceinline__ unsigned xb_xcc_id() { return (unsigned)__builtin_amdgcn_s_getreg((3 << 11) | 20) & 0xFu; }
#define XB_SPIN(cond, bar) do { unsigned _sp = 0; while (cond) { __builtin_amdgcn_s_sleep(1); \
    if ((++_sp & 255u) == 0u) { if (xb_ld(&(bar)[XB_TMO])) break; if (_sp > XB_SPIN_CAP) { atomicAdd(&(bar)[XB_TMO], 1u); break; } } } } while (0)

struct XcdBarrier {
    unsigned* bar; unsigned x;
    volatile LAS unsigned* st;
};

__device__ __forceinline__ XcdBarrier xcd_barrier_post(unsigned* bar, volatile LAS unsigned* st) {
    XcdBarrier b; b.bar = bar; b.x = xb_xcc_id(); b.st = st;
    if (threadIdx.x == 0) (void)xb_add(&bar[XB_XCNT(b.x)], 1u);
    return b;
}
__device__ __forceinline__ void xcd_barrier_complete(unsigned* bar, unsigned x, unsigned& nloc, unsigned& nx) {
    const unsigned G = gridDim.x * gridDim.y * gridDim.z;
    unsigned sum, cnt, mine, sp = 0u;
    for (;;) {
        sum = 0u; cnt = 0u; mine = 0u;
#pragma unroll
        for (unsigned j = 0; j < 16; ++j) { const unsigned c = xb_ld(&bar[XB_XCNT(j)]); sum += c; cnt += (c > 0u) ? 1u : 0u; mine = (j == x) ? c : mine; }
        if (sum == G) break;
        __builtin_amdgcn_s_sleep(1);
        if ((++sp & 255u) == 0u) { if (xb_ld(&bar[XB_TMO])) break; if (sp > XB_SPIN_CAP) { atomicAdd(&bar[XB_TMO], 1u); break; } }
    }
    nloc = mine > 0u ? mine : 1u; nx = cnt > 0u ? cnt : 1u;
}

__device__ __forceinline__ void xcd_barrier(const XcdBarrier& b) {
    asm volatile("s_waitcnt vmcnt(0)" ::: "memory");
    __syncthreads();
    if (threadIdx.x == 0) {
        unsigned* bar = b.bar;
        __builtin_amdgcn_s_waitcnt(0);
        unsigned nloc = b.st[0], nx = b.st[1];
        if (nloc == 0u) { xcd_barrier_complete(bar, b.x, nloc, nx); b.st[0] = nloc; b.st[1] = nx; }
        const unsigned old = xb_add(&bar[XB_XSUB(b.x)], 1u);
        const unsigned gen = old / nloc;
        if (old + 1u == (gen + 1u) * nloc) {
            __builtin_amdgcn_fence(__ATOMIC_RELEASE, "agent");
            asm volatile("s_waitcnt vmcnt(0)" ::: "memory");
            const unsigned og = xb_add(&bar[XB_TOP], 1u);
            const unsigned tg = og / nx;
            if (og + 1u == (tg + 1u) * nx) xb_add(&bar[XB_TOPGEN], 1u);
            else XB_SPIN(xb_ld(&bar[XB_TOPGEN]) == tg, bar);
            __builtin_amdgcn_fence(__ATOMIC_ACQUIRE, "agent");
            xb_add(&bar[XB_XGEN(b.x)], 1u);
            asm volatile("s_waitcnt vmcnt(0)" ::: "memory");
        } else {
            XB_SPIN(xb_ld(&bar[XB_XGEN(b.x)]) == gen, bar);
            __builtin_amdgcn_fence(__ATOMIC_ACQUIRE, "agent");
            asm volatile("s_waitcnt vmcnt(0)" ::: "memory");
        }
    }
    __syncthreads();
}

#define GEMM_PHASE(EPI, SCHED, g, S, E) pg8::gemm_phase<EPI, SCHED, true, true>(Lds, g, S, E)
__global__ void __launch_bounds__(512, 2) mk_fwd(Params P) {
    extern __shared__ __attribute__((aligned(16))) unsigned char lds[];
    cg::grid_group grid = cg::this_grid();
    LAS unsigned char* Lds = (LAS unsigned char*)lds;
    const int tid = threadIdx.x, lane = tid & 63, wave = __builtin_amdgcn_readfirstlane(tid >> 6);
    const int G = gridDim.x, bid = blockIdx.x, gw = bid * 8 + wave, NGW = G * 8;
    unsigned char* ws = P.ws;
    float* ssq = (float*)(ws + WS_SSQ); float* ssqx = ssq + 3 * M;
    if (tid < 8) ((LAS unsigned*)(Lds + LDS_MISC))[tid] = 0u;
    __syncthreads();
    const XcdBarrier xbar = xcd_barrier_post((unsigned*)(ws + WS_BAR), (volatile LAS unsigned*)(Lds + LDS_MISC));
    bf16_t *WGU1 = (bf16_t*)(ws + WS_WGU1), *WD1 = (bf16_t*)(ws + WS_WD1), *WIN = (bf16_t*)(ws + WS_WIN), *WAC = (bf16_t*)(ws + WS_WAC), *WM = (bf16_t*)(ws + WS_WM), *WGU2 = (bf16_t*)(ws + WS_WGU2), *WD2 = (bf16_t*)(ws + WS_WD2);
    bf16_t *H = (bf16_t*)(ws + WS_H), *HFF = (bf16_t*)(ws + WS_HFF), *YRAW = (bf16_t*)(ws + WS_YRAW);
    bf16_t *Qb = (bf16_t*)(ws + WS_Q), *Kb = (bf16_t*)(ws + WS_K), *Vb = (bf16_t*)(ws + WS_V), *CB = (bf16_t*)(ws + WS_CB), *U = (bf16_t*)(ws + WS_U);
    bf16_t *GA = Kb, *GB = Vb, *MRG = U;
    bf16_t *GAs = (bf16_t*)(ws + WS_END) - (size_t)MP * D, *GBs = GAs + (size_t)MS * D;

    {
        LAS float* scr = (LAS float*)(Lds + wave * 16384);
        constexpr int I_GU = 16 * 88, I_DN = 44 * 32, I_W4 = 16 * 128, I_1K = 16 * 32, I_2K = 16 * 64;
        constexpr int NITEMS = 6 * I_GU + I_W4 + 2 * I_1K + I_2K + 3 * I_1K;
        for (int it = gw; it < NITEMS; it += NGW) {
            int r = it;
#define TR(cnt, W, ldw, K, nc, WT, mode, off, gk) if (r < (cnt)) { tr_item(W, ldw, K, nc, WT, mode, off, gk, scr, r, lane); continue; } r -= (cnt);
            TR(I_GU, P.in[7], FF, D, FF, WGU1, 1, 0, P.in[5])
            TR(I_GU, P.in[8], FF, D, FF, WGU1, 1, 128, P.in[5])
            TR(I_DN, P.in[9], D, FF, D, WD1, 0, 0, nullptr)
            TR(I_GU, P.in[26], FF, D, FF, WGU2, 1, 0, P.in[24])
            TR(I_GU, P.in[27], FF, D, FF, WGU2, 1, 128, P.in[24])
            TR(I_DN, P.in[28], D, FF, D, WD2, 0, 0, nullptr)
            TR(I_W4, P.in[12], 8192, D, 4096, WIN, 0, 0, P.in[10])
            TR(I_1K, P.in[12] + 4096, 8192, D, 1024, WIN, 1, 4096, P.in[10])
            TR(I_1K, P.in[12] + 5120, 8192, D, 1024, WIN, 1, 4096 + 128, P.in[10])
            TR(I_2K, P.in[12] + 6144, 8192, D, 2048, WIN, 0, 6144, P.in[10])
            TR(I_1K, P.in[19], D, D, D, WAC, 0, 0, nullptr)
            TR(I_1K, P.in[22], D, D, D, WAC, 0, 1024, nullptr)
            TR(I_1K, P.in[23], D, D, D, WM, 0, 0, nullptr)
#undef TR
        }
        for (int i = bid * 512 + tid; i < 3 * M; i += G * 512) ssq[i] = 0.f;
        x0_rows(P, H, ssqx, gw, NGW, lane);
    }
    float lam;
    { const float d1 = wave_sum(P.in[14][lane] * P.in[15][lane]), d2 = wave_sum(P.in[16][lane] * P.in[17][lane]); lam = expf(d1) - expf(d2) + 0.2f; }
    if (P.pad == 0x7ead) grid.sync();
    xcd_barrier(xbar);
    constexpr int PMP = MP / 256, PMS = MS / 256;
    const int ns = 32; const bool split = G >= 4 * ns;
    const int gwE = split ? (bid - ns) * 8 + wave : gw, NGWE = split ? (G - ns) * 8 : NGW;
    const bool doG = !split || bid < ns, doE = !split || bid >= ns; const int Gs = split ? ns : G;
#define GEMM_RC(EPI, A_, B_, N_, K_, pm0_, nM_, G_, c_, ...) do { pg8::Gemm g_{A_, B_, M, N_, K_, A_, 1 << 30}; RangeOrder S_; S_.init(pm0_, nM_, N_, G_, c_); EPI E_{__VA_ARGS__}; GEMM_PHASE(EPI, RangeOrder, g_, S_, E_); } while (0)
#define GEMM_R(EPI, A_, B_, N_, K_, pm0_, nM_, G_, ...) GEMM_RC(EPI, A_, B_, N_, K_, pm0_, nM_, G_, bid, __VA_ARGS__)
    GEMM_R(EpiSwiGLU, H, WGU1, 2 * FF, D, 0, PMP, G, HFF, ssqx);
    xcd_barrier(xbar);
    GEMM_R(EpiYSsq, HFF, WD1, D, FF, 0, PMP, G, YRAW, ssq);
    GEMM_R(EpiSwiGLU, H, WGU1, 2 * FF, D, PMP, PMS, G, HFF, ssqx);
    xcd_barrier(xbar);
    if (doG) GEMM_R(EpiYSsq, HFF, WD1, D, FF, PMP, PMS, Gs, YRAW, ssq);
    if (doE) ew_rows<true, false>(P, YRAW, ssq, P.in[6], 0.5f, H, ssqx + M, 0, MP, gwE, NGWE, lane);
    xcd_barrier(xbar);
    ew_rows<true, false>(P, YRAW, ssq, P.in[6], 0.5f, H, ssqx + M, MP, M, gw, NGW, lane);
    GEMM_R(EpiWin, H, WIN, 6144, D, 0, PMP, G, Qb, Kb, Vb, CB, U, GA, GB, P.out, P.in[13], 0, ssqx + M);
    xcd_barrier(xbar);
    conv_rows(P, CB, U, 0, MP, gw, NGW, lane);
    for (int k = bid * 2; k < 2048; k += 2 * G) {
        for (int half = 0; half < 2; ++half) {
            const int pu = k >> 1, x = pu & 7, j = (pu >> 3) & 31, i = pu >> 8, bh = x + 8 * i, b = bh >> 3, hd = bh & 7, qblk = half ? 63 - j : j;
            attn_unit<false>(Lds, Qb, Kb, Vb, Qb, nullptr, nullptr, (size_t)b * SEQ + (size_t)qblk * 128, (size_t)b * SEQ, hd, 2 * qblk + 2, lam, P.in[18], true);
        }
    }
    GEMM_R(EpiWin, H, WIN, 6144, D, PMP, PMS, G, Qb, Kb, Vb, CB, U, GA, GB, P.out, P.in[13], 0, ssqx + M);
    GEMM_RC(EpiWin, H, WIN + (size_t)6144 * D, 2048, D, PMP, PMS, G, (bid + PMS * 8) % G, Qb, Kb, Vb, CB, U, GAs, GBs, P.out, P.in[13], 24, ssqx + M);
    xcd_barrier(xbar);
    GEMM_R(EpiWin, H, WIN + (size_t)6144 * D, 2048, D, 0, PMP, G, Qb, Kb, Vb, CB, U, GA, GB, P.out, P.in[13], 24, ssqx + M);
    conv_rows(P, CB, U, MP, M, gw, NGW, lane);
    for (int su = bid; su < 256; su += G) {
        const int b = su >> 3, hd = su & 7;
        attn_unit<true>(Lds, Qb, Kb, Vb, Qb, P.in[2] + (size_t)b * PAST * D, P.in[3] + (size_t)b * PAST * D, (size_t)MP + (size_t)b * DSEQ, 0, hd, PAST / 64 + 1, lam, P.in[18], true);
    }
    xcd_barrier(xbar);
    { pg8::Gemm g{Qb, WAC, M, 2048, D, CB, 4}; PairOrder S{G, bid, 0, PMP * 4}; EpiMerge E{GA, GB, MRG}; GEMM_PHASE(EpiMerge, PairOrder, g, S, E); }
    xcd_barrier(xbar);
    { pg8::Gemm g{MRG, WM, M, D, D, MRG, 1 << 30}; SkipOrder S{G, bid, ns, PMP * 4}; EpiYSsq E{YRAW, ssq + M}; GEMM_PHASE(EpiYSsq, SkipOrder, g, S, E); }
    { pg8::Gemm g{Qb, WAC, M, 2048, D, CB, 4}; PairOrder S{G, bid, PMP, PMS * 4}; EpiMerge E{GAs, GBs, MRG}; GEMM_PHASE(EpiMerge, PairOrder, g, S, E); }
    xcd_barrier(xbar);
    if (doG) GEMM_R(EpiYSsq, MRG, WM, D, D, PMP, PMS, Gs, YRAW, ssq + M);
    if (doE) ew_rows<false, false>(P, YRAW, ssq + M, P.in[11], 1.0f, H, ssqx + 2 * M, 0, MP, gwE, NGWE, lane);
    xcd_barrier(xbar);
    ew_rows<false, false>(P, YRAW, ssq + M, P.in[11], 1.0f, H, ssqx + 2 * M, MP, M, gw, NGW, lane);
    GEMM_R(EpiSwiGLU, H, WGU2, 2 * FF, D, 0, PMP, G, HFF, ssqx + 2 * M);
    xcd_barrier(xbar);
    GEMM_R(EpiYSsq, HFF, WD2, D, FF, 0, PMP, G, YRAW, ssq + 2 * M);
    GEMM_R(EpiSwiGLU, H, WGU2, 2 * FF, D, PMP, PMS, G, HFF, ssqx + 2 * M);
    xcd_barrier(xbar);
    if (doG) GEMM_R(EpiYSsq, HFF, WD2, D, FF, PMP, PMS, Gs, YRAW, ssq + 2 * M);
    if (doE) ew_rows<false, true>(P, YRAW, ssq + 2 * M, P.in[25], 0.5f, H, ssqx, 0, MP, gwE, NGWE, lane);
    xcd_barrier(xbar);
    ew_rows<false, true>(P, YRAW, ssq + 2 * M, P.in[25], 0.5f, H, ssqx, MP, M, gw, NGW, lane);
#undef GEMM_R
}

extern "C" void kernel_launch(void* const* d_in, const int* in_sizes, int n_in, void* d_out, int out_size, void* d_ws, size_t ws_size, hipStream_t stream) {
    static int grid = 0;
    if (grid == 0) {
        if (n_in != 29 || ws_size < WS_END + 8 * MiB) { fprintf(stderr, "kernel_launch: expected 29 inputs and >= %zu bytes of workspace, got %d / %zu\n", (size_t)WS_END, n_in, ws_size); grid = -1; return; }
        int dev = 0, cus = 0, per_cu = 0;
        hipGetDevice(&dev); hipDeviceGetAttribute(&cus, hipDeviceAttributeMultiprocessorCount, dev);
        if (hipFuncSetAttribute((const void*)mk_fwd, hipFuncAttributeMaxDynamicSharedMemorySize, LDS_BYTES) != hipSuccess) fprintf(stderr, "kernel_launch: hipFuncSetAttribute failed\n");
        if (hipOccupancyMaxActiveBlocksPerMultiprocessor(&per_cu, (const void*)mk_fwd, 512, LDS_BYTES) != hipSuccess || per_cu < 1) { fprintf(stderr, "kernel_launch: occupancy query gave %d\n", per_cu); per_cu = 1; }
        (void)hipGetLastError();
        grid = cus * per_cu;
    }
    if (grid < 0) return;
    Params p{};
    for (int i = 0; i < 29; ++i) p.in[i] = (const float*)d_in[i];
    p.out = (float*)d_out; p.ws = (unsigned char*)d_ws; p.nrep = 1;
    if (hipMemsetAsync((char*)d_ws + WS_BAR, 0, XCD_BAR_WORDS * 4, stream) != hipSuccess) fprintf(stderr, "kernel_launch: memset of barrier words failed\n");
    void* args[] = {&p};
    hipError_t e = hipLaunchCooperativeKernel((const void*)mk_fwd, dim3(grid), dim3(512), args, LDS_BYTES, stream);
    if (e != hipSuccess) fprintf(stderr, "cooperative launch failed: %s (grid %d)\n", hipGetErrorString(e), grid);
}
```

```cpp
#include <hip/hip_runtime.h>
#include <hip/hip_cooperative_groups.h>
#include <cstdio>
#include <cstdint>
namespace cg = cooperative_groups;
namespace pg8 {
#define PG8_LAS __attribute__((address_space(3)))
typedef unsigned short bf16_t;
typedef short bf16x8 __attribute__((ext_vector_type(8)));
typedef float f32x4 __attribute__((ext_vector_type(4)));
typedef unsigned u32x4 __attribute__((ext_vector_type(4)));
constexpr int BM = 256, BK = 64, HALF = 128, HTB = HALF * BK * 2  , STAGE_BYTES = 8 * HTB, NXCD = 8, WGM = 8;

__host__ __device__ __forceinline__ int lds_byte(int r, int c) { const int st = (r >> 4) * 2 + (c >> 5), rr = r & 15, cc = c & 31, ob = rr * 64 + cc * 2; return st * 1024 + (ob ^ (((ob >> 9) & 1) << 5)); }
__host__ __device__ __forceinline__ void stage_rc(int b, int& R, int& C) { const int st = b / 1024, sb = b % 1024, swz = sb ^ (((sb >> 9) & 1) << 5); R = (st >> 1) * 16 + swz / 64; C = (st & 1) * 32 + (swz % 64) / 2; }
__host__ __device__ __forceinline__ int perm32(int rho) { const int n = rho >> 4, i = rho & 15; return 8 * (i >> 2) + 4 * n + (i & 3); }

struct Unit { int pm, pn; };
struct Gemm { const bf16_t* A; const bf16_t* Bt; int M, N, K; const bf16_t* A2; int a2pn; };

struct StaticOrder {
    int nM, nN, nwg, G, c;
    __host__ __device__ void init(int M, int N, int G_, int c_) { nM = M / BM; nN = N / BM; nwg = nM * nN; G = G_; c = c_; }
    __host__ __device__ bool next(int i, Unit& u) const {
        const long L = (long)i * G + c; if (L >= nwg) return false;
        int wgid = (int)L; { const int q = nwg / NXCD, r = nwg % NXCD, xcd = wgid % NXCD, off = wgid / NXCD; wgid = (xcd < r ? xcd * (q + 1) : r * (q + 1) + (xcd - r) * q) + off; }
        const int nig = WGM * nN, gid = wgid / nig, fm = gid * WGM, gsz = (nM - fm) < WGM ? (nM - fm) : WGM;
        u.pm = fm + ((wgid % nig) % gsz); u.pn = (wgid % nig) / gsz; return true;
    }
    __device__ __forceinline__ void a_ready(const Unit&) const {}
    __device__ __forceinline__ void done(const Unit&) const {}
};

__device__ __forceinline__ unsigned cvt_pk_bf16(float lo, float hi) { unsigned r; asm volatile("v_cvt_pk_bf16_f32 %0, %1, %2" : "=v"(r) : "v"(lo), "v"(hi)); return r; }
template <class Epi, class Sched, bool ALIGN_EPI = false, bool SP2 = false>
__device__ __forceinline__ void gemm_phase(PG8_LAS unsigned char* lds, const Gemm g, const Sched& S, const Epi& E) {
    int tid_l = threadIdx.x; asm volatile("" : "+v"(tid_l));
    const int tid = tid_l, wid = __builtin_amdgcn_readfirstlane(tid >> 6), lane = tid & 63, wr = wid >> 2, wc = wid & 3, fr = lane & 15, fq = lane >> 4;
    const int K = g.K, nt = K / BK;
    unsigned voffA[2], voffB[2];
#pragma unroll
    for (int i = 0; i < 2; ++i) { int R, C; stage_rc(tid * 16 + i * 8192, R, C); const int Rb = Epi::PERM ? ((R & ~31) + perm32(R & 31)) : R;
        voffA[i] = (unsigned)(R * K + C) * 2u; voffB[i] = (unsigned)(Rb * K + C) * 2u; }
    const size_t kstep = (size_t)(BK * 2);
    const size_t hstep = (size_t)HALF * K * 2;
    const size_t tstep = 2 * hstep;
    const unsigned ldsw = (unsigned)wid * 1024u;
    const int aoff = lds_byte(wr * 64 + fr, fq * 8), boff = lds_byte(wc * 32 + fr, fq * 8);
#define PG8_SA(b, h) (((b) * 2 + (h)) * HTB)
#define PG8_SB(b, h) ((4 + (b) * 2 + (h)) * HTB)
#define PG8_STAGE(bufoff, gbase, voff) do { _Pragma("unroll") for (int _i = 0; _i < 2; ++_i) \
        __builtin_amdgcn_global_load_lds((const unsigned*)((const char*)(gbase) + (voff)[_i]), (PG8_LAS unsigned*)(lds + (bufoff) + ldsw + _i * 8192), 16, 0, 0); } while (0)
#define PG8_LDA(dst, b, h) do { _Pragma("unroll") for (int m = 0; m < 4; ++m) _Pragma("unroll") for (int k = 0; k < 2; ++k) dst[m][k] = *(const PG8_LAS bf16x8*)(lds + PG8_SA(b, h) + aoff + m * 2048 + k * 1024); } while (0)
#define PG8_LDB(dst, b, h) do { _Pragma("unroll") for (int n = 0; n < 2; ++n) _Pragma("unroll") for (int k = 0; k < 2; ++k) dst[n][k] = *(const PG8_LAS bf16x8*)(lds + PG8_SB(b, h) + boff + n * 2048 + k * 1024); } while (0)
#define PG8_MMA(ai, bj, At, Bt) do { __builtin_amdgcn_s_setprio(1); _Pragma("unroll") for (int m = 0; m < 4; ++m) _Pragma("unroll") for (int n = 0; n < 2; ++n) _Pragma("unroll") for (int k = 0; k < 2; ++k) \
        acc[ai][bj][m][n] = __builtin_amdgcn_mfma_f32_16x16x32_bf16(Bt[n][k], At[m][k], acc[ai][bj][m][n], 0, 0, 0); __builtin_amdgcn_s_setprio(0); } while (0)
#define PG8_WAIT_V(n) asm volatile("s_waitcnt vmcnt(" #n ")" ::: "memory")
#define PG8_WAIT_L(n) asm volatile("s_waitcnt lgkmcnt(" #n ")" ::: "memory")
#define PG8_BAR __builtin_amdgcn_s_barrier()
#define PG8_SCHED __builtin_amdgcn_sched_barrier(0)
    Unit cur, nxt; int ui = 0;
    if (!S.next(0, cur)) return;
    f32x4 acc[2][2][4][2];
#pragma unroll
    for (int a = 0; a < 2; ++a)
#pragma unroll
        for (int b = 0; b < 2; ++b)
#pragma unroll
            for (int m = 0; m < 4; ++m)
#pragma unroll
                for (int n = 0; n < 2; ++n) acc[a][b][m][n] = (f32x4){0.f, 0.f, 0.f, 0.f};
    bf16x8 At[4][2], B0[2][2], B1[2][2];
    const char* cA = (const char*)(cur.pn >= g.a2pn ? g.A2 : g.A) + (size_t)cur.pm * tstep; const char* cB = (const char*)g.Bt + (size_t)cur.pn * tstep;
    S.a_ready(cur);
    if constexpr (SP2) {
        PG8_STAGE(PG8_SB(0, 0), cB, voffB); PG8_STAGE(PG8_SB(0, 1), cB + hstep, voffB); PG8_STAGE(PG8_SA(0, 0), cA, voffA); PG8_STAGE(PG8_SA(0, 1), cA + hstep, voffA);
        if (wr == 1) PG8_BAR;
        PG8_WAIT_V(2); PG8_BAR;
        PG8_STAGE(PG8_SB(1, 0), cB + kstep, voffB); PG8_STAGE(PG8_SA(1, 0), cA + kstep, voffA); PG8_STAGE(PG8_SB(1, 1), cB + hstep + kstep, voffB);
        PG8_WAIT_V(6); PG8_BAR;
    } else {
        PG8_STAGE(PG8_SB(0, 0), cB, voffB); PG8_STAGE(PG8_SA(0, 0), cA, voffA); PG8_STAGE(PG8_SB(0, 1), cB + hstep, voffB); PG8_STAGE(PG8_SA(0, 1), cA + hstep, voffA);
        if (wr == 1) PG8_BAR;
        PG8_WAIT_V(4); PG8_BAR;
        PG8_STAGE(PG8_SB(1, 0), cB + kstep, voffB); PG8_STAGE(PG8_SA(1, 0), cA + kstep, voffA); PG8_STAGE(PG8_SB(1, 1), cB + hstep + kstep, voffB);
        PG8_WAIT_V(6); PG8_BAR;
    }
    for (;;) {
        const bool has_next = S.next(ui + 1, nxt);
        const char* nA = has_next ? (const char*)(nxt.pn >= g.a2pn ? g.A2 : g.A) + (size_t)nxt.pm * tstep : cA; const char* nB = has_next ? (const char*)g.Bt + (size_t)nxt.pn * tstep : cB;
        for (int t = 0; t < nt; t += 2) {
            const bool last = (t == nt - 2);
            const char* a1 = cA + (size_t)(t + 1) * kstep;
            const char* a2 = last ? nA : cA + (size_t)(t + 2) * kstep; const char* b2 = last ? nB : cB + (size_t)(t + 2) * kstep;
            const char* a3 = a2 + kstep; const char* b3 = b2 + kstep;
            if (last && has_next) S.a_ready(nxt);
            if constexpr (SP2) {
            PG8_LDB(B0, 0, 0); PG8_LDB(B1, 0, 1); PG8_SCHED; PG8_LDA(At, 0, 0); PG8_STAGE(PG8_SA(1, 1), a1 + hstep, voffA);
            PG8_WAIT_V(8); PG8_WAIT_L(0); PG8_BAR; PG8_MMA(0, 0, At, B0); PG8_MMA(0, 1, At, B1); PG8_BAR; PG8_SCHED;
            PG8_LDA(At, 0, 1); PG8_STAGE(PG8_SB(0, 0), b2, voffB); PG8_STAGE(PG8_SB(0, 1), b2 + hstep, voffB); PG8_STAGE(PG8_SA(0, 0), a2, voffA);
            PG8_WAIT_V(8); PG8_WAIT_L(0); PG8_BAR; PG8_MMA(1, 0, At, B0); PG8_MMA(1, 1, At, B1); PG8_BAR; PG8_SCHED;
            PG8_LDB(B0, 1, 0); PG8_LDB(B1, 1, 1); PG8_SCHED; PG8_LDA(At, 1, 0); PG8_STAGE(PG8_SA(0, 1), a2 + hstep, voffA);
            PG8_WAIT_V(8); PG8_WAIT_L(0); PG8_BAR; PG8_MMA(0, 0, At, B0); PG8_MMA(0, 1, At, B1); PG8_BAR; PG8_SCHED;
            PG8_LDA(At, 1, 1); PG8_STAGE(PG8_SB(1, 0), b3, voffB); PG8_STAGE(PG8_SB(1, 1), b3 + hstep, voffB); PG8_STAGE(PG8_SA(1, 0), a3, voffA);
            PG8_WAIT_V(8); PG8_WAIT_L(0); PG8_BAR; PG8_MMA(1, 0, At, B0); PG8_MMA(1, 1, At, B1); PG8_BAR; PG8_SCHED;
            } else {
            PG8_LDB(B0, 0, 0); PG8_SCHED; PG8_LDA(At, 0, 0); PG8_STAGE(PG8_SA(1, 1), a1 + hstep, voffA);
            PG8_WAIT_L(8); PG8_BAR; PG8_WAIT_L(0); PG8_MMA(0, 0, At, B0); PG8_BAR; PG8_SCHED;
            PG8_LDB(B1, 0, 1); PG8_STAGE(PG8_SB(0, 0), b2, voffB);
            PG8_BAR; PG8_WAIT_L(0); PG8_MMA(0, 1, At, B1); PG8_BAR;
            PG8_LDA(At, 0, 1); PG8_STAGE(PG8_SA(0, 0), a2, voffA);
            PG8_BAR; PG8_WAIT_L(0); PG8_MMA(1, 0, At, B0); PG8_BAR; PG8_SCHED;
            PG8_STAGE(PG8_SB(0, 1), b2 + hstep, voffB);
            PG8_WAIT_V(6); PG8_BAR; PG8_MMA(1, 1, At, B1); PG8_BAR;
            PG8_LDB(B0, 1, 0); PG8_SCHED; PG8_LDA(At, 1, 0); PG8_STAGE(PG8_SA(0, 1), a2 + hstep, voffA);
            PG8_WAIT_L(8); PG8_BAR; PG8_WAIT_L(0); PG8_MMA(0, 0, At, B0); PG8_BAR; PG8_SCHED;
            PG8_LDB(B1, 1, 1); PG8_STAGE(PG8_SB(1, 0), b3, voffB);
            PG8_BAR; PG8_WAIT_L(0); PG8_MMA(0, 1, At, B1); PG8_BAR;
            PG8_LDA(At, 1, 1); PG8_STAGE(PG8_SA(1, 0), a3, voffA);
            PG8_BAR; PG8_WAIT_L(0); PG8_MMA(1, 0, At, B0); PG8_BAR; PG8_SCHED;
            PG8_STAGE(PG8_SB(1, 1), b3 + hstep, voffB);
            PG8_WAIT_V(6); PG8_BAR; PG8_MMA(1, 1, At, B1); PG8_BAR;
            }
        }
        if constexpr (ALIGN_EPI) { if (wr == 0) PG8_BAR; }
        if constexpr (!Epi::AFTER_DRAIN) { E(acc, cur, wr, wc, fr, fq); S.done(cur); }
        if (!has_next) break;
#pragma unroll
        for (int a = 0; a < 2; ++a)
#pragma unroll
            for (int b = 0; b < 2; ++b)
#pragma unroll
                for (int m = 0; m < 4; ++m)
#pragma unroll
                    for (int n = 0; n < 2; ++n) acc[a][b][m][n] = (f32x4){0.f, 0.f, 0.f, 0.f};
        cur = nxt; cA = nA; cB = nB; ++ui;
        if constexpr (ALIGN_EPI) { if (wr == 1) PG8_BAR; }
    }
    PG8_WAIT_V(0);
    if constexpr (!ALIGN_EPI) { if (wr == 0) PG8_BAR; }
    PG8_BAR;
    if constexpr (Epi::AFTER_DRAIN) { E.fused(acc, cur, wr, wc, fr, fq, lds, wid, lane); S.done(cur); }
#undef PG8_SA
#undef PG8_SB
#undef PG8_STAGE
#undef PG8_LDA
#undef PG8_LDB
#undef PG8_MMA
#undef PG8_WAIT_V
#undef PG8_WAIT_L
#undef PG8_BAR
#undef PG8_SCHED
}
}

#define LAS __attribute__((address_space(3)))
using pg8::bf16_t; using pg8::bf16x8; using pg8::f32x4; using pg8::u32x4;
typedef float f32x16 __attribute__((ext_vector_type(16)));
typedef short s16x4 __attribute__((ext_vector_type(4)));
typedef unsigned u32x2 __attribute__((ext_vector_type(2)));
constexpr int MP = 32768, MS = 2048, M = MP + MS;
constexpr int D = 1024, FF = 2816, SEQ = 8192, DSEQ = 64, PAST = 1024;
constexpr float EPS = 1e-6f;
constexpr float C2 = 0.125f * 1.4426950408889634f;
constexpr size_t OKP = (size_t)M * D, OVP = OKP + (size_t)MP * D, OCP = OVP + (size_t)MP * D, OKS = OCP + 4 * 2 * D, OVS = OKS + (size_t)MS * D, OCS = OVS + (size_t)MS * D;
constexpr size_t MiB = 1u << 20;
constexpr size_t WS_SSQ = 0, WS_WGU1 = 1 * MiB, WS_WD1 = 12 * MiB, WS_WIN = 18 * MiB, WS_WAC = 34 * MiB, WS_WM = 38 * MiB, WS_WGU2 = 40 * MiB, WS_WD2 = 51 * MiB;
constexpr size_t WS_H = 60 * MiB, WS_HFF = 128 * MiB, WS_YRAW = 332 * MiB;
constexpr size_t WS_Q = 128 * MiB, WS_K = 196 * MiB, WS_V = 264 * MiB, WS_CB = 332 * MiB, WS_U = 400 * MiB, WS_END = 468 * MiB;
constexpr int LDS_BYTES = 163840;
constexpr size_t WS_BAR = 896 * 1024;
constexpr int LDS_MISC = 4 * 38912 + 256;

struct Params { const float* in[29]; float* out; unsigned char* ws; int nrep, pad; };

__device__ __forceinline__ unsigned pk2(float lo, float hi) { typedef float f2 __attribute__((ext_vector_type(2))); typedef __bf16 b2 __attribute__((ext_vector_type(2))); f2 v = {lo, hi}; b2 b = __builtin_convertvector(v, b2); return __builtin_bit_cast(unsigned, b); }
__device__ __forceinline__ float bf_lo(unsigned w) { return __uint_as_float(w << 16); }
__device__ __forceinline__ float bf_hi(unsigned w) { return __uint_as_float(w & 0xffff0000u); }
__device__ __forceinline__ u32x4 pack8(f32x4 a, f32x4 b) { u32x4 w; w.x = pk2(a[0], a[1]); w.y = pk2(a[2], a[3]); w.z = pk2(b[0], b[1]); w.w = pk2(b[2], b[3]); return w; }
__device__ __forceinline__ void unpack8(u32x4 w, f32x4& a, f32x4& b) { a = (f32x4){bf_lo(w.x), bf_hi(w.x), bf_lo(w.y), bf_hi(w.y)}; b = (f32x4){bf_lo(w.z), bf_hi(w.z), bf_lo(w.w), bf_hi(w.w)}; }
__device__ __forceinline__ float wave_sum(float v) {
#pragma unroll
    for (int o = 1; o < 64; o <<= 1) v += __shfl_xor(v, o);
    return v;
}
__device__ __forceinline__ float sigmoidf_fast(float x) { return __builtin_amdgcn_rcpf(1.f + __builtin_amdgcn_exp2f(-1.4426950409f * x)); }

struct EpiSwiGLU {
    static constexpr bool PERM = true, AFTER_DRAIN = false;
    bf16_t* O; const float* ssqx;
    __device__ __forceinline__ void operator()(const f32x4 (&acc)[2][2][4][2], const pg8::Unit& u, int wr, int wc, int fr, int fq) const {
        const int row0 = u.pm * 256 + wr * 64 + fr, col0 = u.pn * 128 + wc * 32 + 8 * fq;
#pragma unroll
        for (int ai = 0; ai < 2; ++ai)
#pragma unroll
            for (int m = 0; m < 4; ++m) {
                f32x4 v[2]; const float rs = rsqrtf(ssqx[row0 + ai * 128 + m * 16] * (1.f / D) + EPS);
#pragma unroll
                for (int n = 0; n < 2; ++n)
#pragma unroll
                    for (int i = 0; i < 4; ++i) { const float g = acc[ai][0][m][n][i] * rs; v[n][i] = g * sigmoidf_fast(g) * (acc[ai][1][m][n][i] * rs); }
                *(u32x4*)(O + (size_t)(row0 + ai * 128 + m * 16) * FF + col0) = pack8(v[0], v[1]);
            }
    }
};
struct EpiYSsq {
    static constexpr bool PERM = true, AFTER_DRAIN = false;
    bf16_t* Y; float* ssq;
    __device__ __forceinline__ void operator()(const f32x4 (&acc)[2][2][4][2], const pg8::Unit& u, int wr, int wc, int fr, int fq) const {
        const int row0 = u.pm * 256 + wr * 64 + fr, col0 = u.pn * 256 + wc * 32 + 8 * fq;
#pragma unroll
        for (int ai = 0; ai < 2; ++ai)
#pragma unroll
            for (int m = 0; m < 4; ++m) {
                const int row = row0 + ai * 128 + m * 16; float s = 0.f;
#pragma unroll
                for (int bj = 0; bj < 2; ++bj) { const f32x4 a = acc[ai][bj][m][0], b = acc[ai][bj][m][1];
                    s += (a[0] * a[0] + a[1] * a[1]) + (a[2] * a[2] + a[3] * a[3]) + (b[0] * b[0] + b[1] * b[1]) + (b[2] * b[2] + b[3] * b[3]);
                    *(u32x4*)(Y + (size_t)row * D + col0 + bj * 128) = pack8(a, b); }
                s += __shfl_xor(s, 16); s += __shfl_xor(s, 32);
                if (fq == 0) unsafeAtomicAdd(ssq + row, s);
            }
    }
};
struct EpiWin {
    static constexpr bool PERM = true, AFTER_DRAIN = false;
    bf16_t *Q, *Kb, *Vb, *CB, *U, *GA, *GB; float* out; const float* bgate; int pn_off; const float* ssqx;
    __device__ __forceinline__ void operator()(const f32x4 (&acc)[2][2][4][2], const pg8::Unit& u, int wr, int wc, int fr, int fq) const {
        const int pn = u.pn + pn_off, row0 = u.pm * 256 + wr * 64 + fr, cw = wc * 32 + 8 * fq;
        float rsv[2][4];
#pragma unroll
        for (int ai = 0; ai < 2; ++ai)
#pragma unroll
            for (int m = 0; m < 4; ++m) rsv[ai][m] = rsqrtf(ssqx[row0 + ai * 128 + m * 16] * (1.f / D) + EPS);
        if (pn < 4) {
#pragma unroll
            for (int ai = 0; ai < 2; ++ai)
#pragma unroll
                for (int m = 0; m < 4; ++m)
#pragma unroll
                    for (int bj = 0; bj < 2; ++bj)
                        *(u32x4*)(Q + (size_t)(row0 + ai * 128 + m * 16) * D + pn * 256 + bj * 128 + cw) = pack8(acc[ai][bj][m][0] * (C2 * rsv[ai][m]), acc[ai][bj][m][1] * (C2 * rsv[ai][m]));
        } else if (pn < 12) {
            const bool isv = pn >= 8; const int cb = (pn - (isv ? 8 : 4)) * 256 + cw;
            bf16_t* bd = isv ? Vb : Kb;
            float* od = (u.pm < MP / 256) ? out + (isv ? OVP : OKP) : out + (isv ? OVS : OKS) - (size_t)MP * D;
#pragma unroll
            for (int ai = 0; ai < 2; ++ai)
#pragma unroll
                for (int m = 0; m < 4; ++m)
#pragma unroll
                    for (int bj = 0; bj < 2; ++bj) { const size_t off = (size_t)(row0 + ai * 128 + m * 16) * D + cb + bj * 128;
                        const f32x4 a = acc[ai][bj][m][0] * rsv[ai][m], b = acc[ai][bj][m][1] * rsv[ai][m];
                        *(u32x4*)(bd + off) = pack8(a, b);
                        *(f32x4*)(od + off) = a; *(f32x4*)(od + off + 4) = b; }
        } else if (pn < 16) {
#pragma unroll
            for (int ai = 0; ai < 2; ++ai)
#pragma unroll
                for (int m = 0; m < 4; ++m)
#pragma unroll
                    for (int bj = 0; bj < 2; ++bj)
                        *(u32x4*)(CB + (size_t)(row0 + ai * 128 + m * 16) * D + (pn - 12) * 256 + bj * 128 + cw) = pack8(acc[ai][bj][m][0] * rsv[ai][m], acc[ai][bj][m][1] * rsv[ai][m]);
        } else if (pn < 24) {
#pragma unroll
            for (int ai = 0; ai < 2; ++ai)
#pragma unroll
                for (int m = 0; m < 4; ++m)
                    *(u32x4*)(U + (size_t)(row0 + ai * 128 + m * 16) * D + (pn - 16) * 128 + cw) = pack8(acc[ai][0][m][0] * acc[ai][1][m][0] * (rsv[ai][m] * rsv[ai][m]), acc[ai][0][m][1] * acc[ai][1][m][1] * (rsv[ai][m] * rsv[ai][m]));
        } else {
            const bool isb = pn >= 28; const int cb = (pn - (isb ? 28 : 24)) * 256 + cw;
            bf16_t* gd = isb ? GB : GA; const float* bias = bgate + (isb ? D : 0) + cb;
#pragma unroll
            for (int bj = 0; bj < 2; ++bj) { const f32x4 b0 = *(const f32x4*)(bias + bj * 128), b1 = *(const f32x4*)(bias + bj * 128 + 4);
#pragma unroll
                for (int ai = 0; ai < 2; ++ai)
#pragma unroll
                    for (int m = 0; m < 4; ++m) { f32x4 a = acc[ai][bj][m][0] * rsv[ai][m] + b0, b = acc[ai][bj][m][1] * rsv[ai][m] + b1;
#pragma unroll
                        for (int i = 0; i < 4; ++i) { a[i] = sigmoidf_fast(a[i]); b[i] = sigmoidf_fast(b[i]); }
                        *(u32x4*)(gd + (size_t)(row0 + ai * 128 + m * 16) * D + cb + bj * 128) = pack8(a, b); } }
        }
    }
};
struct EpiMerge {
    static constexpr bool PERM = true, AFTER_DRAIN = false;
    const bf16_t *GA, *GB; bf16_t* MRG;
    __device__ __forceinline__ void operator()(const f32x4 (&acc)[2][2][4][2], const pg8::Unit& u, int wr, int wc, int fr, int fq) const {
        const bool second = u.pn >= 4; const int row0 = u.pm * 256 + wr * 64 + fr, col0 = (u.pn & 3) * 256 + wc * 32 + 8 * fq;
        const bf16_t* G = second ? GB : GA;
#pragma unroll
        for (int ai = 0; ai < 2; ++ai)
#pragma unroll
            for (int m = 0; m < 4; ++m)
#pragma unroll
                for (int bj = 0; bj < 2; ++bj) { const size_t off = (size_t)(row0 + ai * 128 + m * 16) * D + col0 + bj * 128;
                    f32x4 g0, g1; unpack8(*(const u32x4*)(G + off), g0, g1);
                    f32x4 a = acc[ai][bj][m][0] * g0, b = acc[ai][bj][m][1] * g1;
                    if (second) { f32x4 p0, p1; unpack8(*(const u32x4*)(MRG + off), p0, p1); a += p0; b += p1; }
                    *(u32x4*)(MRG + off) = pack8(a, b); }
    }
};
struct PairOrder {
    int G, c, pm0, nL;
    __device__ bool next(int i, pg8::Unit& u) const { const int L = (i >> 1) * G + c; if (L >= nL) return false; u.pm = pm0 + (L >> 2); u.pn = (L & 3) + 4 * (i & 1); return true; }
    __device__ __forceinline__ void a_ready(const pg8::Unit&) const {}
    __device__ __forceinline__ void done(const pg8::Unit&) const {}
};
struct RangeOrder {
    pg8::StaticOrder S; int pm0;
    __device__ void init(int pm0_, int nM, int N, int G, int c) { S.init(nM * 256, N, G, c); pm0 = pm0_; }
    __device__ bool next(int i, pg8::Unit& u) const { if (!S.next(i, u)) return false; u.pm += pm0; return true; }
    __device__ __forceinline__ void a_ready(const pg8::Unit&) const {}
    __device__ __forceinline__ void done(const pg8::Unit&) const {}
};
struct SkipOrder {
    int G, c, ns, nL;
    __device__ bool next(int i, pg8::Unit& u) const {
        int L;
        if (G == 256 && nL == 512) { if (i == 0) L = c; else if (i == 1) { if (c < ns) return false; L = 256 + (c - ns); } else if (i == 2) { if (c < ns || c >= 2 * ns) return false; L = 512 - ns + (c - ns); } else return false; }
        else { L = i * G + c; if (L >= nL) return false; }
        u.pm = L >> 2; u.pn = L & 3; return true;
    }
    __device__ __forceinline__ void a_ready(const pg8::Unit&) const {}
    __device__ __forceinline__ void done(const pg8::Unit&) const {}
};

__device__ __forceinline__ void tr_item(const float* W, int ldw, int K, int ncols, bf16_t* WT, int mode, int row_off, const float* gk, LAS float* scr, int item, int lane) {
    const int nblk = ncols / 32, kb = item / nblk, nb = item % nblk, k0 = 64 * kb, n0 = 32 * nb;
#pragma unroll 8
    for (int i = 0; i < 32; ++i) { const int kk = 2 * i + (lane >> 5); scr[kk * 33 + (lane & 31)] = W[(size_t)(k0 + kk) * ldw + n0 + (lane & 31)] * (gk ? gk[k0 + kk] : 1.f); }
    asm volatile("s_waitcnt lgkmcnt(0)" ::: "memory");
    const int c = lane & 7, drow0 = row_off + (mode ? 256 * (n0 >> 7) + (n0 & 127) : n0);
#pragma unroll
    for (int j = 0; j < 4; ++j) { const int n = (lane >> 3) + 8 * j; const LAS float* s = scr + (8 * c) * 33 + n;
        u32x4 o; o.x = pk2(s[0 * 33], s[1 * 33]); o.y = pk2(s[2 * 33], s[3 * 33]); o.z = pk2(s[4 * 33], s[5 * 33]); o.w = pk2(s[6 * 33], s[7 * 33]);
        *(u32x4*)(WT + (size_t)(drow0 + n) * K + k0 + 8 * c) = o; }
    asm volatile("s_waitcnt lgkmcnt(0)" ::: "memory");
}
__device__ __forceinline__ const float* xrow_in(const Params& P, int r) { return r < MP ? P.in[0] + (size_t)r * D : P.in[1] + (size_t)(r - MP) * D; }

__device__ __forceinline__ void x0_rows(const Params& P, bf16_t* XB, float* ssqx, int gw, int NGW, int lane) {
    for (int r = gw; r < M; r += NGW) {
        const f32x4* xr = (const f32x4*)xrow_in(P, r); f32x4 v[4]; float s = 0.f;
#pragma unroll
        for (int j = 0; j < 4; ++j) { v[j] = xr[lane + 64 * j]; s += (v[j][0] * v[j][0] + v[j][1] * v[j][1]) + (v[j][2] * v[j][2] + v[j][3] * v[j][3]); }
        const float tot = wave_sum(s);
#pragma unroll
        for (int j = 0; j < 4; ++j) *(u32x2*)(XB + (size_t)r * D + (lane + 64 * j) * 4) = (u32x2){pk2(v[j][0], v[j][1]), pk2(v[j][2], v[j][3])};
        if (lane == 0) ssqx[r] = tot;
    }
}
template <bool FIRST, bool LAST>
__device__ __forceinline__ void ew_rows(const Params& P, const bf16_t* Y, const float* ssq, const float* gpost, float scale, bf16_t* XB, float* ssqx_out, int r_lo, int r_hi, int gw, int NGW, int lane) {
    for (int r = r_lo + gw; r < r_hi; r += NGW) {
        const float rs = rsqrtf(ssq[r] * (1.f / D) + EPS) * scale; float s = 0.f;
#pragma unroll
        for (int j = 0; j < 4; ++j) { const u32x2 yw = *(const u32x2*)(Y + (size_t)r * D + (lane + 64 * j) * 4); const f32x4 y = {bf_lo(yw.x), bf_hi(yw.x), bf_lo(yw.y), bf_hi(yw.y)};
            f32x4 xin;
            if (FIRST) xin = ((const f32x4*)xrow_in(P, r))[lane + 64 * j];
            else { const u32x2 xw = *(const u32x2*)(XB + (size_t)r * D + (lane + 64 * j) * 4); xin = (f32x4){bf_lo(xw.x), bf_hi(xw.x), bf_lo(xw.y), bf_hi(xw.y)}; }
            const f32x4 v = xin + y * rs * ((const f32x4*)gpost)[lane + 64 * j];
            if (LAST) ((f32x4*)(P.out + (size_t)r * D))[lane + 64 * j] = v;
            else { *(u32x2*)(XB + (size_t)r * D + (lane + 64 * j) * 4) = (u32x2){pk2(v[0], v[1]), pk2(v[2], v[3])}; s += (v[0] * v[0] + v[1] * v[1]) + (v[2] * v[2] + v[3] * v[3]); } }
        if (!LAST) { const float tot = wave_sum(s); if (lane == 0) ssqx_out[r] = tot; }
    }
}
__device__ __forceinline__ void conv_rows(const Params& P, bf16_t* CB, const bf16_t* U, int r_lo, int r_hi, int gw, int NGW, int lane) {
    const float* cw = P.in[20]; const float* cbias = P.in[21]; const float* st = P.in[4];
    for (int r = r_lo + gw; r < r_hi; r += NGW) {
        const bool samp = r >= MP; const int b = samp ? (r - MP) >> 6 : r >> 13, t = samp ? (r - MP) & 63 : r & 8191, T = samp ? DSEQ : SEQ;
#pragma unroll
        for (int jj = 0; jj < 2; ++jj) { const int c = (lane + 64 * jj) * 8;
            f32x4 u0a, u0b, u1a, u1b, u2a, u2b, ca, cb2; const f32x4 z4 = {0.f, 0.f, 0.f, 0.f};
            unpack8(*(const u32x4*)(U + (size_t)r * D + c), u0a, u0b);
            if (t >= 1) unpack8(*(const u32x4*)(U + (size_t)(r - 1) * D + c), u1a, u1b);
            else if (samp) { u1a = *(const f32x4*)(st + ((size_t)b * 2 + 1) * D + c); u1b = *(const f32x4*)(st + ((size_t)b * 2 + 1) * D + c + 4); } else { u1a = z4; u1b = z4; }
            if (t >= 2) unpack8(*(const u32x4*)(U + (size_t)(r - 2) * D + c), u2a, u2b);
            else if (samp) { u2a = *(const f32x4*)(st + ((size_t)b * 2 + t) * D + c); u2b = *(const f32x4*)(st + ((size_t)b * 2 + t) * D + c + 4); } else { u2a = z4; u2b = z4; }
            unpack8(*(const u32x4*)(CB + (size_t)r * D + c), ca, cb2);
            const f32x4 w0a = *(const f32x4*)(cw + c), w0b = *(const f32x4*)(cw + c + 4), w1a = *(const f32x4*)(cw + D + c), w1b = *(const f32x4*)(cw + D + c + 4), w2a = *(const f32x4*)(cw + 2 * D + c), w2b = *(const f32x4*)(cw + 2 * D + c + 4);
            const f32x4 ba = *(const f32x4*)(cbias + c), bb = *(const f32x4*)(cbias + c + 4);
            const f32x4 za = ba + w0a * u2a + w1a * u1a + w2a * u0a, zb = bb + w0b * u2b + w1b * u1b + w2b * u0b;
            *(u32x4*)(CB + (size_t)r * D + c) = pack8(ca * za, cb2 * zb);
            if (t >= T - 2) { float* o = P.out + (samp ? OCS : OCP) + ((size_t)b * 2 + (t - (T - 2))) * D + c; *(f32x4*)o = u0a; *(f32x4*)(o + 4) = u0b; }
        }
    }
}

constexpr int KROW = 144, VROW = 320, KBUF = 64 * KROW, STAGE = 2 * KBUF + 64 * VROW;
typedef short v4i16_t __attribute__((ext_vector_type(4)));
__device__ __forceinline__ s16x4 vtr(const LAS unsigned char* p) { return __builtin_bit_cast(s16x4, __builtin_amdgcn_ds_read_tr16_b64_v4i16((LAS v4i16_t*)p)); }
#define MFMA32(a, b, c) __builtin_amdgcn_mfma_f32_32x32x16_bf16((a), (b), (c), 0, 0, 0)
__device__ __forceinline__ void glds16(const void* gsrc, unsigned lds_dst) { unsigned keep;
    asm volatile("s_mov_b32 %0, m0\n\ts_mov_b32 m0, %2\n\ts_nop 0\n\tglobal_load_lds_dwordx4 %1, off\n\ts_mov_b32 m0, %0" : "=&s"(keep) : "v"(gsrc), "s"(lds_dst) : "memory"); }
__device__ __forceinline__ bf16x8 packp(const f32x16& p, int b) { u32x4 w; w.x = pk2(p[b], p[b + 1]); w.y = pk2(p[b + 2], p[b + 3]); w.z = pk2(p[b + 4], p[b + 5]); w.w = pk2(p[b + 6], p[b + 7]); return __builtin_bit_cast(bf16x8, w); }
#define SBAR() __builtin_amdgcn_sched_barrier(0)
__device__ __forceinline__ void attn_tile(const LAS unsigned char* st, int map, int lane, const bf16x8 (&qf)[4], f32x16 (&o)[4], f32x16& lsum, float& m_run, bool first) {
    const int r32 = lane & 31, hh = lane >> 5;
    const LAS unsigned char* kp = st + map * KBUF + r32 * KROW + hh * 16;
    const LAS unsigned char* vp = st + 2 * KBUF + (4 * hh + ((lane & 15) >> 2)) * VROW + 32 * ((lane >> 4) & 1) + 8 * (lane & 3);
    f32x16 p0, p1;
    { const float nm = -m_run;
#pragma unroll
      for (int i = 0; i < 16; ++i) { p0[i] = nm; p1[i] = nm; } }
    bf16x8 kf[8]; s16x4 vlo[2][4], vhi[2][4];
    SBAR();
#pragma unroll
    for (int ds = 0; ds < 4; ++ds) { kf[2 * ds] = *(const LAS bf16x8*)(kp + ds * 32); kf[2 * ds + 1] = *(const LAS bf16x8*)(kp + 32 * KROW + ds * 32); }
#pragma unroll
    for (int d = 0; d < 4; ++d) { vlo[0][d] = vtr(vp + d * 64); vhi[0][d] = vtr(vp + 8 * VROW + d * 64); }
    SBAR();
#pragma unroll
    for (int ds = 0; ds < 4; ++ds) { p0 = MFMA32(kf[2 * ds], qf[ds], p0); p1 = MFMA32(kf[2 * ds + 1], qf[ds], p1); }
    SBAR();
    f32x16 e0, e1;
#pragma unroll
    for (int i = 0; i < 16; ++i) { e0[i] = __builtin_amdgcn_exp2f(p0[i]); e1[i] = __builtin_amdgcn_exp2f(p1[i]); }
    float mt = fmaxf(fmaxf(e0[0], e1[0]), e0[1]);
#pragma unroll
    for (int i = 1; i < 16; ++i) mt = (i == 1) ? fmaxf(mt, e1[1]) : fmaxf(fmaxf(mt, e0[i]), e1[i]);
    { auto rr = __builtin_amdgcn_permlane32_swap(__float_as_uint(mt), __float_as_uint(mt), false, false); mt = fmaxf(__uint_as_float(rr[0]), __uint_as_float(rr[1])); }
    if (first || __any(!(mt <= 256.f))) {
        float rm = fmaxf(p0[0], p1[0]);
#pragma unroll
        for (int i = 1; i < 16; ++i) rm = fmaxf(rm, fmaxf(p0[i], p1[i]));
        { auto rr = __builtin_amdgcn_permlane32_swap(__float_as_uint(rm), __float_as_uint(rm), false, false); rm = fmaxf(__uint_as_float(rr[0]), __uint_as_float(rr[1])); }
        const float dl = first ? rm : fmaxf(rm, 0.f);
        m_run += dl;
#pragma unroll
        for (int i = 0; i < 16; ++i) { e0[i] = __builtin_amdgcn_exp2f(p0[i] - dl); e1[i] = __builtin_amdgcn_exp2f(p1[i] - dl); }
        if (!first) { const float a = __builtin_amdgcn_exp2f(-dl);
#pragma unroll
            for (int i = 0; i < 16; ++i) lsum[i] *= a;
#pragma unroll
            for (int d = 0; d < 4; ++d)
#pragma unroll
                for (int i = 0; i < 16; ++i) o[d][i] *= a; }
    }
    bf16x8 pf[4]; pf[0] = packp(e0, 0); pf[1] = packp(e0, 8); pf[2] = packp(e1, 0); pf[3] = packp(e1, 8);
    const bf16x8 ones = {(short)0x3F80, (short)0x3F80, (short)0x3F80, (short)0x3F80, (short)0x3F80, (short)0x3F80, (short)0x3F80, (short)0x3F80};
    SBAR();
#pragma unroll
    for (int ks = 0; ks < 4; ++ks) {
        if (ks < 3) {
#pragma unroll
            for (int d = 0; d < 4; ++d) { vlo[(ks + 1) & 1][d] = vtr(vp + (ks + 1) * 16 * VROW + d * 64); vhi[(ks + 1) & 1][d] = vtr(vp + (ks + 1) * 16 * VROW + 8 * VROW + d * 64); }
            SBAR();
        }
#pragma unroll
        for (int d = 0; d < 4; ++d) { const bf16x8 a = __builtin_shufflevector(vlo[ks & 1][d], vhi[ks & 1][d], 0, 1, 2, 3, 4, 5, 6, 7); o[d] = MFMA32(a, pf[ks], o[d]); }
        lsum = MFMA32(ones, pf[ks], lsum);
        SBAR();
    }
}
__device__ __forceinline__ void attn_qk(const LAS unsigned char* st, int map, int lane, const bf16x8 (&qf)[4], float m_run, f32x16& p0, f32x16& p1) {
    const int r32 = lane & 31, hh = lane >> 5;
    const LAS unsigned char* kp = st + map * KBUF + r32 * KROW + hh * 16;
    { const float nm = -m_run;
#pragma unroll
      for (int i = 0; i < 16; ++i) { p0[i] = nm; p1[i] = nm; } }
    bf16x8 kf[8];
    SBAR();
#pragma unroll
    for (int ds = 0; ds < 4; ++ds) { kf[2 * ds] = *(const LAS bf16x8*)(kp + ds * 32); kf[2 * ds + 1] = *(const LAS bf16x8*)(kp + 32 * KROW + ds * 32); }
    SBAR();
#pragma unroll
    for (int ds = 0; ds < 4; ++ds) { p0 = MFMA32(kf[2 * ds], qf[ds], p0); p1 = MFMA32(kf[2 * ds + 1], qf[ds], p1); }
    SBAR();
}
template <bool PV>
__device__ __forceinline__ void attn_exp_pv(const LAS unsigned char* stv, int lane, const bf16x8 (&pf)[4], f32x16 (&o)[4], f32x16& lsum, const f32x16& p0, const f32x16& p1, f32x16& e0, f32x16& e1, float& mt) {
    const int hh = lane >> 5;
    const LAS unsigned char* vp = stv + 2 * KBUF + (4 * hh + ((lane & 15) >> 2)) * VROW + 32 * ((lane >> 4) & 1) + 8 * (lane & 3);
    const bf16x8 ones = {(short)0x3F80, (short)0x3F80, (short)0x3F80, (short)0x3F80, (short)0x3F80, (short)0x3F80, (short)0x3F80, (short)0x3F80};
    SBAR();
    if (PV) {
        s16x4 vlo[2][4], vhi[2][4];
#pragma unroll
        for (int d = 0; d < 4; ++d) { vlo[0][d] = vtr(vp + d * 64); vhi[0][d] = vtr(vp + 8 * VROW + d * 64); }
        SBAR();
#pragma unroll
        for (int ks = 0; ks < 4; ++ks) {
            if (ks < 3) {
#pragma unroll
                for (int d = 0; d < 4; ++d) { vlo[(ks + 1) & 1][d] = vtr(vp + (ks + 1) * 16 * VROW + d * 64); vhi[(ks + 1) & 1][d] = vtr(vp + (ks + 1) * 16 * VROW + 8 * VROW + d * 64); }
                SBAR();
            }
#pragma unroll
            for (int d = 0; d < 5; ++d) {
                if (d < 4) { const bf16x8 a = __builtin_shufflevector(vlo[ks & 1][d], vhi[ks & 1][d], 0, 1, 2, 3, 4, 5, 6, 7); o[d] = MFMA32(a, pf[ks], o[d]); }
                else lsum = MFMA32(ones, pf[ks], lsum);
                const int g = ks * 5 + d;
                if (g < 16) { e0[g] = __builtin_amdgcn_exp2f(p0[g]); e1[g] = __builtin_amdgcn_exp2f(p1[g]); }
                else {
#pragma unroll
                    for (int i = 4 * (g - 16); i < 4 * (g - 16) + 4; ++i) mt = (i == 0) ? fmaxf(e0[0], e1[0]) : fmaxf(fmaxf(mt, e0[i]), e1[i]);
                }
                SBAR();
            }
        }
    } else {
#pragma unroll
        for (int i = 0; i < 16; ++i) { e0[i] = __builtin_amdgcn_exp2f(p0[i]); e1[i] = __builtin_amdgcn_exp2f(p1[i]); }
        mt = fmaxf(e0[0], e1[0]);
#pragma unroll
        for (int i = 1; i < 16; ++i) mt = fmaxf(fmaxf(mt, e0[i]), e1[i]);
    }
    SBAR();
}
__device__ __forceinline__ void attn_decide_pack(const f32x16& p0, const f32x16& p1, f32x16& e0, f32x16& e1, float mt, f32x16 (&o)[4], f32x16& lsum, float& m_run, bool first, bf16x8 (&pf)[4]) {
    { auto rr = __builtin_amdgcn_permlane32_swap(__float_as_uint(mt), __float_as_uint(mt), false, false); mt = fmaxf(__uint_as_float(rr[0]), __uint_as_float(rr[1])); }
    if (first || __any(!(mt <= 256.f))) {
        float rm = fmaxf(p0[0], p1[0]);
#pragma unroll
        for (int i = 1; i < 16; ++i) rm = fmaxf(rm, fmaxf(p0[i], p1[i]));
        { auto rr = __builtin_amdgcn_permlane32_swap(__float_as_uint(rm), __float_as_uint(rm), false, false); rm = fmaxf(__uint_as_float(rr[0]), __uint_as_float(rr[1])); }
        const float dl = first ? rm : fmaxf(rm, 0.f);
        m_run += dl;
#pragma unroll
        for (int i = 0; i < 16; ++i) { e0[i] = __builtin_amdgcn_exp2f(p0[i] - dl); e1[i] = __builtin_amdgcn_exp2f(p1[i] - dl); }
        if (!first) { const float a = __builtin_amdgcn_exp2f(-dl);
#pragma unroll
            for (int i = 0; i < 16; ++i) lsum[i] *= a;
#pragma unroll
            for (int d = 0; d < 4; ++d)
#pragma unroll
                for (int i = 0; i < 16; ++i) o[d][i] *= a; }
    }
    pf[0] = packp(e0, 0); pf[1] = packp(e0, 8); pf[2] = packp(e1, 0); pf[3] = packp(e1, 8);
}
template <bool SAMPLE>
__device__ __forceinline__ void attn_unit(LAS unsigned char* L, const bf16_t* Qb, const bf16_t* Kb, const bf16_t* Vb, bf16_t* Ob, const float* cK, const float* cV,
                                          size_t qrow0, size_t kvrow0, int head, int NT, float lam, const float* subg, bool do_store) {
    int tid_l = threadIdx.x; asm volatile("" : "+v"(tid_l));
    const int tid = tid_l, lane = tid & 63, r32 = lane & 31, hh = lane >> 5;
    const int wid = __builtin_amdgcn_readfirstlane(tid >> 6), map = wid >> 2, qg = wid & 3;
    const bool active = SAMPLE ? (qg < 2) : true;
    const int nvis = SAMPLE ? NT : ((qg < 2) ? NT - 1 : NT);
    bf16x8 qf[4];
    { const bf16_t* qp = Qb + (qrow0 + (active ? qg * 32 + r32 : 0)) * D + head * 128 + map * 64 + hh * 8;
#pragma unroll
      for (int ds = 0; ds < 4; ++ds) qf[ds] = *(const bf16x8*)(qp + ds * 16); }
    asm volatile("" : "+v"(qf[0]), "+v"(qf[1]), "+v"(qf[2]), "+v"(qf[3]));
    f32x16 o[4];
#pragma unroll
    for (int d = 0; d < 4; ++d)
#pragma unroll
        for (int i = 0; i < 16; ++i) o[d][i] = 0.f;
    float m_run = 0.f; f32x16 lsum;
#pragma unroll
    for (int i = 0; i < 16; ++i) lsum[i] = 0.f;
    const int skey = tid >> 4, sch = tid & 15;
    const size_t gofs = (size_t)skey * D + head * 128 + sch * 8;
    const int dK = (sch >> 3) * KBUF + skey * KROW + (sch & 7) * 16, dV = 2 * KBUF + skey * VROW + sch * 16;
    if (!SAMPLE) {
        const bf16_t* src[5]; unsigned dsto[5];
#pragma unroll
        for (int j = 0; j < 5; ++j) { int p = wid + 8 * j; if (p > 37) p -= 2; const int c = 64 * p + lane; dsto[j] = (unsigned)p * 1024u;
            if (p < 18) { const int mp = c / 576, rc = c - mp * 576, row = rc / 9; int col = rc - row * 9; if (col == 8) col = 0; src[j] = Kb + (kvrow0 + row) * D + head * 128 + mp * 64 + col * 8; }
            else { const int c2 = c - 1152, row = c2 / 20, col = (c2 - row * 20) & 15; src[j] = Vb + (kvrow0 + row) * D + head * 128 + col * 8; } }
        const unsigned lds0 = (unsigned)(uintptr_t)L;
#define AT_DMA(t, sb) do { _Pragma("unroll") for (int j_ = 0; j_ < 5; ++j_) glds16(src[j_] + (size_t)(t) * 64 * D, (unsigned)__builtin_amdgcn_readfirstlane(lds0 + (sb) + dsto[j_])); } while (0)
        bf16x8 pf[4]; f32x16 p0, p1, e0, e1; float mt;
        AT_DMA(0, 0); AT_DMA(1, STAGE);
        asm volatile("s_waitcnt vmcnt(5) lgkmcnt(0)\n\ts_barrier" ::: "memory");
        for (int t = 0; t < NT; ++t) {
            if (t + 2 < NT) AT_DMA(t + 2, ((t + 2) & 3) * STAGE);
            if (t < nvis) {
                attn_qk(L + (t & 3) * STAGE, map, lane, qf, m_run, p0, p1);
                if (t == 0) attn_exp_pv<false>(L, lane, pf, o, lsum, p0, p1, e0, e1, mt);
                else attn_exp_pv<true>(L + ((t - 1) & 3) * STAGE, lane, pf, o, lsum, p0, p1, e0, e1, mt);
                attn_decide_pack(p0, p1, e0, e1, mt, o, lsum, m_run, t == 0, pf);
            }
            if (t + 2 < NT) asm volatile("s_waitcnt vmcnt(5) lgkmcnt(0)\n\ts_barrier" ::: "memory");
            else asm volatile("s_waitcnt vmcnt(0) lgkmcnt(0)\n\ts_barrier" ::: "memory");
        }
        { f32x16 z0 = p0, z1 = p1; float mt2;
          attn_exp_pv<true>(L + ((nvis - 1) & 3) * STAGE, lane, pf, o, lsum, z0, z1, e0, e1, mt2); }
        __syncthreads();
    } else {
        const int key = tid >> 5, f4 = tid & 31;
        f32x4 fk[4], fv[4];
#define AT_LOADF(t) do { _Pragma("unroll") for (int i_ = 0; i_ < 4; ++i_) { const size_t src_ = ((size_t)((t) * 64 + key + 16 * i_) * 8 + head) * 128 + f4 * 4; fk[i_] = *(const f32x4*)(cK + src_); fv[i_] = *(const f32x4*)(cV + src_); } } while (0)
        AT_LOADF(0);
        for (int t = 0; t < NT; ++t) {
            LAS unsigned char* s_ = L + (t & 1) * STAGE;
            if (t < PAST / 64) {
#pragma unroll
                for (int i = 0; i < 4; ++i) {
                    *(LAS u32x2*)(s_ + (f4 >> 4) * KBUF + (key + 16 * i) * KROW + (f4 & 15) * 8) = (u32x2){pk2(fk[i][0], fk[i][1]), pk2(fk[i][2], fk[i][3])};
                    *(LAS u32x2*)(s_ + 2 * KBUF + (key + 16 * i) * VROW + f4 * 8) = (u32x2){pk2(fv[i][0], fv[i][1]), pk2(fv[i][2], fv[i][3])}; }
            } else {
                u32x4 rk0, rk1, rv0, rv1;
                { const bf16_t* kp_ = Kb + qrow0 * D + gofs; const bf16_t* vp_ = Vb + qrow0 * D + gofs;
                  rk0 = *(const u32x4*)kp_; rk1 = *(const u32x4*)(kp_ + 32 * D); rv0 = *(const u32x4*)vp_; rv1 = *(const u32x4*)(vp_ + 32 * D); }
                *(LAS u32x4*)(s_ + dK) = rk0; *(LAS u32x4*)(s_ + dK + 32 * KROW) = rk1; *(LAS u32x4*)(s_ + dV) = rv0; *(LAS u32x4*)(s_ + dV + 32 * VROW) = rv1;
            }
            __syncthreads();
            if (t + 1 < PAST / 64) AT_LOADF(t + 1);
            if (active) attn_tile(s_, map, lane, qf, o, lsum, m_run, t == 0);
        }
        __syncthreads();
    }
    const float inv = active ? 1.f / lsum[0] : 0.f;
    LAS float* X = (LAS float*)L;
    if (active && map == 1) {
#pragma unroll
        for (int d = 0; d < 4; ++d)
#pragma unroll
            for (int i = 0; i < 16; ++i) X[((qg * 4 + d) * 16 + i) * 64 + lane] = o[d][i] * inv;
    }
    __syncthreads();
    if (active && map == 0 && do_store) {
        float ss = 0.f;
#pragma unroll
        for (int d = 0; d < 4; ++d)
#pragma unroll
            for (int i = 0; i < 16; ++i) { const float v = o[d][i] * inv - lam * X[((qg * 4 + d) * 16 + i) * 64 + lane]; o[d][i] = v; ss += v * v; }
        ss += __shfl_xor(ss, 32);
        const float rs = rsqrtf(ss * (1.f / 128.f) + EPS) * 0.8f;
        bf16_t* op = Ob + (qrow0 + qg * 32 + r32) * D + head * 128 + 4 * hh;
#pragma unroll
        for (int d = 0; d < 4; ++d)
#pragma unroll
            for (int g4 = 0; g4 < 4; ++g4) { const f32x4 gg = *(const f32x4*)(subg + 32 * d + 8 * g4 + 4 * hh);
                *(u32x2*)(op + 32 * d + 8 * g4) = (u32x2){pk2(o[d][4 * g4] * rs * gg[0], o[d][4 * g4 + 1] * rs * gg[1]), pk2(o[d][4 * g4 + 2] * rs * gg[2], o[d][4 * g4 + 3] * rs * gg[3])}; }
    }
    __syncthreads();
}

#define XB_TMO      128
#define XB_XCNT(j)  (256  + 64 * (j))
#define XB_XSUB(j)  (1280 + 64 * (j))
#define XB_XGEN(j)  (2304 + 64 * (j))
#define XB_TOP      3328
#define XB_TOPGEN   3392
#define XCD_BAR_WORDS 3456
#define XB_SPIN_CAP (1u << 18)

__device__ __forceinline__ unsigned xb_ld(unsigned* p)              { return __hip_atomic_load(p, __ATOMIC_RELAXED, __HIP_MEMORY_SCOPE_AGENT); }
__device__ __forceinline__ unsigned xb_add(unsigned* p, unsigned v) { return __hip_atomic_fetch_add(p, v, __ATOMIC_RELAXED, __HIP_MEMORY_SCOPE_AGENT); }
__device__ __forceinline__ unsigned xb_xcc_id() { return (unsigned)__builtin_amdgcn_s_getreg((3 << 11) | 20) & 0xFu; }
#define XB_SPIN(cond, bar) do { unsigned _sp = 0; while (cond) { __builtin_amdgcn_s_sleep(1); \
    if ((++_sp & 255u) == 0u) { if (xb_ld(&(bar)[XB_TMO])) break; if (_sp > XB_SPIN_CAP) { atomicAdd(&(bar)[XB_TMO], 1u); break; } } } } while (0)

struct XcdBarrier {
    unsigned* bar; unsigned x;
    volatile LAS unsigned* st;
};

__device__ __forceinline__ XcdBarrier xcd_barrier_post(unsigned* bar, volatile LAS unsigned* st) {
    XcdBarrier b; b.bar = bar; b.x = xb_xcc_id(); b.st = st;
    if (threadIdx.x == 0) (void)xb_add(&bar[XB_XCNT(b.x)], 1u);
    return b;
}
__device__ __forceinline__ void xcd_barrier_complete(unsigned* bar, unsigned x, unsigned& nloc, unsigned& nx) {
    const unsigned G = gridDim.x * gridDim.y * gridDim.z;
    unsigned sum, cnt, mine, sp = 0u;
    for (;;) {
        sum = 0u; cnt = 0u; mine = 0u;
#pragma unroll
        for (unsigned j = 0; j < 16; ++j) { const unsigned c = xb_ld(&bar[XB_XCNT(j)]); sum += c; cnt += (c > 0u) ? 1u : 0u; mine = (j == x) ? c : mine; }
        if (sum == G) break;
        __builtin_amdgcn_s_sleep(1);
        if ((++sp & 255u) == 0u) { if (xb_ld(&bar[XB_TMO])) break; if (sp > XB_SPIN_CAP) { atomicAdd(&bar[XB_TMO], 1u); break; } }
    }
    nloc = mine > 0u ? mine : 1u; nx = cnt > 0u ? cnt : 1u;
}

__device__ __forceinline__ void xcd_barrier(const XcdBarrier& b) {
    asm volatile("s_waitcnt vmcnt(0)" ::: "memory");
    __syncthreads();
    if (threadIdx.x == 0) {
        unsigned* bar = b.bar;
        __builtin_amdgcn_s_waitcnt(0);
        unsigned nloc = b.st[0], nx = b.st[1];
        if (nloc == 0u) { xcd_barrier_complete(bar, b.x, nloc, nx); b.st[0] = nloc; b.st[1] = nx; }
        const unsigned old = xb_add(&bar[XB_XSUB(b.x)], 1u);
        const unsigned gen = old / nloc;
        if (old + 1u == (gen + 1u) * nloc) {
            __builtin_amdgcn_fence(__ATOMIC_RELEASE, "agent");
            asm volatile("s_waitcnt vmcnt(0)" ::: "memory");
            const unsigned og = xb_add(&bar[XB_TOP], 1u);
            const unsigned tg = og / nx;
            if (og + 1u == (tg + 1u) * nx) xb_add(&bar[XB_TOPGEN], 1u);
            else XB_SPIN(xb_ld(&bar[XB_TOPGEN]) == tg, bar);
            __builtin_amdgcn_fence(__ATOMIC_ACQUIRE, "agent");
            xb_add(&bar[XB_XGEN(b.x)], 1u);
            asm volatile("s_waitcnt vmcnt(0)" ::: "memory");
        } else {
            XB_SPIN(xb_ld(&bar[XB_XGEN(b.x)]) == gen, bar);
            __builtin_amdgcn_fence(__ATOMIC_ACQUIRE, "agent");
            asm volatile("s_waitcnt vmcnt(0)" ::: "memory");
        }
    }
    __syncthreads();
}

#define GEMM_PHASE(EPI, SCHED, g, S, E) pg8::gemm_phase<EPI, SCHED, true, true>(Lds, g, S, E)
__global__ void __launch_bounds__(512, 2) mk_fwd(Params P) {
    extern __shared__ __attribute__((aligned(16))) unsigned char lds[];
    cg::grid_group grid = cg::this_grid();
    LAS unsigned char* Lds = (LAS unsigned char*)lds;
    const int tid = threadIdx.x, lane = tid & 63, wave = __builtin_amdgcn_readfirstlane(tid >> 6);
    const int G = gridDim.x, bid = blockIdx.x, gw = bid * 8 + wave, NGW = G * 8;
    unsigned char* ws = P.ws;
    float* ssq = (float*)(ws + WS_SSQ); float* ssqx = ssq + 3 * M;
    if (tid < 8) ((LAS unsigned*)(Lds + LDS_MISC))[tid] = 0u;
    __syncthreads();
    const XcdBarrier xbar = xcd_barrier_post((unsigned*)(ws + WS_BAR), (volatile LAS unsigned*)(Lds + LDS_MISC));
    bf16_t *WGU1 = (bf16_t*)(ws + WS_WGU1), *WD1 = (bf16_t*)(ws + WS_WD1), *WIN = (bf16_t*)(ws + WS_WIN), *WAC = (bf16_t*)(ws + WS_WAC), *WM = (bf16_t*)(ws + WS_WM), *WGU2 = (bf16_t*)(ws + WS_WGU2), *WD2 = (bf16_t*)(ws + WS_WD2);
    bf16_t *H = (bf16_t*)(ws + WS_H), *HFF = (bf16_t*)(ws + WS_HFF), *YRAW = (bf16_t*)(ws + WS_YRAW);
    bf16_t *Qb = (bf16_t*)(ws + WS_Q), *Kb = (bf16_t*)(ws + WS_K), *Vb = (bf16_t*)(ws + WS_V), *CB = (bf16_t*)(ws + WS_CB), *U = (bf16_t*)(ws + WS_U);
    bf16_t *GA = Kb, *GB = Vb, *MRG = U;
    bf16_t *GAs = (bf16_t*)(ws + WS_END) - (size_t)MP * D, *GBs = GAs + (size_t)MS * D;

    {
        LAS float* scr = (LAS float*)(Lds + wave * 16384);
        constexpr int I_GU = 16 * 88, I_DN = 44 * 32, I_W4 = 16 * 128, I_1K = 16 * 32, I_2K = 16 * 64;
        constexpr int NITEMS = 6 * I_GU + I_W4 + 2 * I_1K + I_2K + 3 * I_1K;
        for (int it = gw; it < NITEMS; it += NGW) {
            int r = it;
#define TR(cnt, W, ldw, K, nc, WT, mode, off, gk) if (r < (cnt)) { tr_item(W, ldw, K, nc, WT, mode, off, gk, scr, r, lane); continue; } r -= (cnt);
            TR(I_GU, P.in[7], FF, D, FF, WGU1, 1, 0, P.in[5])
            TR(I_GU, P.in[8], FF, D, FF, WGU1, 1, 128, P.in[5])
            TR(I_DN, P.in[9], D, FF, D, WD1, 0, 0, nullptr)
            TR(I_GU, P.in[26], FF, D, FF, WGU2, 1, 0, P.in[24])
            TR(I_GU, P.in[27], FF, D, FF, WGU2, 1, 128, P.in[24])
            TR(I_DN, P.in[28], D, FF, D, WD2, 0, 0, nullptr)
            TR(I_W4, P.in[12], 8192, D, 4096, WIN, 0, 0, P.in[10])
            TR(I_1K, P.in[12] + 4096, 8192, D, 1024, WIN, 1, 4096, P.in[10])
            TR(I_1K, P.in[12] + 5120, 8192, D, 1024, WIN, 1, 4096 + 128, P.in[10])
            TR(I_2K, P.in[12] + 6144, 8192, D, 2048, WIN, 0, 6144, P.in[10])
            TR(I_1K, P.in[19], D, D, D, WAC, 0, 0, nullptr)
            TR(I_1K, P.in[22], D, D, D, WAC, 0, 1024, nullptr)
            TR(I_1K, P.in[23], D, D, D, WM, 0, 0, nullptr)
#undef TR
        }
        for (int i = bid * 512 + tid; i < 3 * M; i += G * 512) ssq[i] = 0.f;
        x0_rows(P, H, ssqx, gw, NGW, lane);
    }
    float lam;
    { const float d1 = wave_sum(P.in[14][lane] * P.in[15][lane]), d2 = wave_sum(P.in[16][lane] * P.in[17][lane]); lam = expf(d1) - expf(d2) + 0.2f; }
    if (P.pad == 0x7ead) grid.sync();
    xcd_barrier(xbar);
    constexpr int PMP = MP / 256, PMS = MS / 256;
    const int ns = 32; const bool split = G >= 4 * ns;
    const int gwE = split ? (bid - ns) * 8 + wave : gw, NGWE = split ? (G - ns) * 8 : NGW;
    const bool doG = !split || bid < ns, doE = !split || bid >= ns; const int Gs = split ? ns : G;
#define GEMM_RC(EPI, A_, B_, N_, K_, pm0_, nM_, G_, c_, ...) do { pg8::Gemm g_{A_, B_, M, N_, K_, A_, 1 << 30}; RangeOrder S_; S_.init(pm0_, nM_, N_, G_, c_); EPI E_{__VA_ARGS__}; GEMM_PHASE(EPI, RangeOrder, g_, S_, E_); } while (0)
#define GEMM_R(EPI, A_, B_, N_, K_, pm0_, nM_, G_, ...) GEMM_RC(EPI, A_, B_, N_, K_, pm0_, nM_, G_, bid, __VA_ARGS__)
    GEMM_R(EpiSwiGLU, H, WGU1, 2 * FF, D, 0, PMP, G, HFF, ssqx);
    xcd_barrier(xbar);
    GEMM_R(EpiYSsq, HFF, WD1, D, FF, 0, PMP, G, YRAW, ssq);
    GEMM_R(EpiSwiGLU, H, WGU1, 2 * FF, D, PMP, PMS, G, HFF, ssqx);
    xcd_barrier(xbar);
    if (doG) GEMM_R(EpiYSsq, HFF, WD1, D, FF, PMP, PMS, Gs, YRAW, ssq);
    if (doE) ew_rows<true, false>(P, YRAW, ssq, P.in[6], 0.5f, H, ssqx + M, 0, MP, gwE, NGWE, lane);
    xcd_barrier(xbar);
    ew_rows<true, false>(P, YRAW, ssq, P.in[6], 0.5f, H, ssqx + M, MP, M, gw, NGW, lane);
    GEMM_R(EpiWin, H, WIN, 6144, D, 0, PMP, G, Qb, Kb, Vb, CB, U, GA, GB, P.out, P.in[13], 0, ssqx + M);
    xcd_barrier(xbar);
    conv_rows(P, CB, U, 0, MP, gw, NGW, lane);
    for (int k = bid * 2; k < 2048; k += 2 * G) {
        for (int half = 0; half < 2; ++half) {
            const int pu = k >> 1, x = pu & 7, j = (pu >> 3) & 31, i = pu >> 8, bh = x + 8 * i, b = bh >> 3, hd = bh & 7, qblk = half ? 63 - j : j;
            attn_unit<false>(Lds, Qb, Kb, Vb, Qb, nullptr, nullptr, (size_t)b * SEQ + (size_t)qblk * 128, (size_t)b * SEQ, hd, 2 * qblk + 2, lam, P.in[18], true);
        }
    }
    GEMM_R(EpiWin, H, WIN, 6144, D, PMP, PMS, G, Qb, Kb, Vb, CB, U, GA, GB, P.out, P.in[13], 0, ssqx + M);
    GEMM_RC(EpiWin, H, WIN + (size_t)6144 * D, 2048, D, PMP, PMS, G, (bid + PMS * 8) % G, Qb, Kb, Vb, CB, U, GAs, GBs, P.out, P.in[13], 24, ssqx + M);
    xcd_barrier(xbar);
    GEMM_R(EpiWin, H, WIN + (size_t)6144 * D, 2048, D, 0, PMP, G, Qb, Kb, Vb, CB, U, GA, GB, P.out, P.in[13], 24, ssqx + M);
    conv_rows(P, CB, U, MP, M, gw, NGW, lane);
    for (int su = bid; su < 256; su += G) {
        const int b = su >> 3, hd = su & 7;
        attn_unit<true>(Lds, Qb, Kb, Vb, Qb, P.in[2] + (size_t)b * PAST * D, P.in[3] + (size_t)b * PAST * D, (size_t)MP + (size_t)b * DSEQ, 0, hd, PAST / 64 + 1, lam, P.in[18], true);
    }
    xcd_barrier(xbar);
    { pg8::Gemm g{Qb, WAC, M, 2048, D, CB, 4}; PairOrder S{G, bid, 0, PMP * 4}; EpiMerge E{GA, GB, MRG}; GEMM_PHASE(EpiMerge, PairOrder, g, S, E); }
    xcd_barrier(xbar);
    { pg8::Gemm g{MRG, WM, M, D, D, MRG, 1 << 30}; SkipOrder S{G, bid, ns, PMP * 4}; EpiYSsq E{YRAW, ssq + M}; GEMM_PHASE(EpiYSsq, SkipOrder, g, S, E); }
    { pg8::Gemm g{Qb, WAC, M, 2048, D, CB, 4}; PairOrder S{G, bid, PMP, PMS * 4}; EpiMerge E{GAs, GBs, MRG}; GEMM_PHASE(EpiMerge, PairOrder, g, S, E); }
    xcd_barrier(xbar);
    if (doG) GEMM_R(EpiYSsq, MRG, WM, D, D, PMP, PMS, Gs, YRAW, ssq + M);
    if (doE) ew_rows<false, false>(P, YRAW, ssq + M, P.in[11], 1.0f, H, ssqx + 2 * M, 0, MP, gwE, NGWE, lane);
    xcd_barrier(xbar);
    ew_rows<false, false>(P, YRAW, ssq + M, P.in[11], 1.0f, H, ssqx + 2 * M, MP, M, gw, NGW, lane);
    GEMM_R(EpiSwiGLU, H, WGU2, 2 * FF, D, 0, PMP, G, HFF, ssqx + 2 * M);
    xcd_barrier(xbar);
    GEMM_R(EpiYSsq, HFF, WD2, D, FF, 0, PMP, G, YRAW, ssq + 2 * M);
    GEMM_R(EpiSwiGLU, H, WGU2, 2 * FF, D, PMP, PMS, G, HFF, ssqx + 2 * M);
    xcd_barrier(xbar);
    if (doG) GEMM_R(EpiYSsq, HFF, WD2, D, FF, PMP, PMS, Gs, YRAW, ssq + 2 * M);
    if (doE) ew_rows<false, true>(P, YRAW, ssq + 2 * M, P.in[25], 0.5f, H, ssqx, 0, MP, gwE, NGWE, lane);
    xcd_barrier(xbar);
    ew_rows<false, true>(P, YRAW, ssq + 2 * M, P.in[25], 0.5f, H, ssqx, MP, M, gw, NGW, lane);
#undef GEMM_R
}

extern "C" void kernel_launch(void* const* d_in, const int* in_sizes, int n_in, void* d_out, int out_size, void* d_ws, size_t ws_size, hipStream_t stream) {
    static int grid = 0;
    if (grid == 0) {
        if (n_in != 29 || ws_size < WS_END + 8 * MiB) { fprintf(stderr, "kernel_launch: expected 29 inputs and >= %zu bytes of workspace, got %d / %zu\n", (size_t)WS_END, n_in, ws_size); grid = -1; return; }
        int dev = 0, cus = 0, per_cu = 0;
        hipGetDevice(&dev); hipDeviceGetAttribute(&cus, hipDeviceAttributeMultiprocessorCount, dev);
        if (hipFuncSetAttribute((const void*)mk_fwd, hipFuncAttributeMaxDynamicSharedMemorySize, LDS_BYTES) != hipSuccess) fprintf(stderr, "kernel_launch: hipFuncSetAttribute failed\n");
        if (hipOccupancyMaxActiveBlocksPerMultiprocessor(&per_cu, (const void*)mk_fwd, 512, LDS_BYTES) != hipSuccess || per_cu < 1) { fprintf(stderr, "kernel_launch: occupancy query gave %d\n", per_cu); per_cu = 1; }
        (void)hipGetLastError();
        grid = cus * per_cu;
    }
    if (grid < 0) return;
    Params p{};
    for (int i = 0; i < 29; ++i) p.in[i] = (const float*)d_in[i];
    p.out = (float*)d_out; p.ws = (unsigned char*)d_ws; p.nrep = 1;
    if (hipMemsetAsync((char*)d_ws + WS_BAR, 0, XCD_BAR_WORDS * 4, stream) != hipSuccess) fprintf(stderr, "kernel_launch: memset of barrier words failed\n");
    void* args[] = {&p};
    hipError_t e = hipLaunchCooperativeKernel((const void*)mk_fwd, dim3(grid), dim3(512), args, LDS_BYTES, stream);
    if (e != hipSuccess) fprintf(stderr, "cooperative launch failed: %s (grid %d)\n", hipGetErrorString(e), grid);
}
```

```cpp
#include <hip/hip_runtime.h>
#include <hip/hip_cooperative_groups.h>
#include <cstdio>
#include <cstdint>
namespace cg = cooperative_groups;
namespace pg8 {
#define PG8_LAS __attribute__((address_space(3)))
typedef unsigned short bf16_t;
typedef short bf16x8 __attribute__((ext_vector_type(8)));
typedef float f32x4 __attribute__((ext_vector_type(4)));
typedef unsigned u32x4 __attribute__((ext_vector_type(4)));
constexpr int BM = 256, BK = 64, HALF = 128, HTB = HALF * BK * 2  , STAGE_BYTES = 8 * HTB, NXCD = 8, WGM = 8;

__host__ __device__ __forceinline__ int lds_byte(int r, int c) { const int st = (r >> 4) * 2 + (c >> 5), rr = r & 15, cc = c & 31, ob = rr * 64 + cc * 2; return st * 1024 + (ob ^ (((ob >> 9) & 1) << 5)); }
__host__ __device__ __forceinline__ void stage_rc(int b, int& R, int& C) { const int st = b / 1024, sb = b % 1024, swz = sb ^ (((sb >> 9) & 1) << 5); R = (st >> 1) * 16 + swz / 64; C = (st & 1) * 32 + (swz % 64) / 2; }
__host__ __device__ __forceinline__ int perm32(int rho) { const int n = rho >> 4, i = rho & 15; return 8 * (i >> 2) + 4 * n + (i & 3); }

struct Unit { int pm, pn; };
struct Gemm { const bf16_t* A; const bf16_t* Bt; int M, N, K; const bf16_t* A2; int a2pn; };

struct StaticOrder {
    int nM, nN, nwg, G, c;
    __host__ __device__ void init(int M, int N, int G_, int c_) { nM = M / BM; nN = N / BM; nwg = nM * nN; G = G_; c = c_; }
    __host__ __device__ bool next(int i, Unit& u) const {
        const long L = (long)i * G + c; if (L >= nwg) return false;
        int wgid = (int)L; { const int q = nwg / NXCD, r = nwg % NXCD, xcd = wgid % NXCD, off = wgid / NXCD; wgid = (xcd < r ? xcd * (q + 1) : r * (q + 1) + (xcd - r) * q) + off; }
        const int nig = WGM * nN, gid = wgid / nig, fm = gid * WGM, gsz = (nM - fm) < WGM ? (nM - fm) : WGM;
        u.pm = fm + ((wgid % nig) % gsz); u.pn = (wgid % nig) / gsz; return true;
    }
    __device__ __forceinline__ void a_ready(const Unit&) const {}
    __device__ __forceinline__ void done(const Unit&) const {}
};

__device__ __forceinline__ unsigned cvt_pk_bf16(float lo, float hi) { unsigned r; asm volatile("v_cvt_pk_bf16_f32 %0, %1, %2" : "=v"(r) : "v"(lo), "v"(hi)); return r; }
template <class Epi, class Sched, bool ALIGN_EPI = false, bool SP2 = false>
__device__ __forceinline__ void gemm_phase(PG8_LAS unsigned char* lds, const Gemm g, const Sched& S, const Epi& E) {
    int tid_l = threadIdx.x; asm volatile("" : "+v"(tid_l));
    const int tid = tid_l, wid = __builtin_amdgcn_readfirstlane(tid >> 6), lane = tid & 63, wr = wid >> 2, wc = wid & 3, fr = lane & 15, fq = lane >> 4;
    const int K = g.K, nt = K / BK;
    unsigned voffA[2], voffB[2];
#pragma unroll
    for (int i = 0; i < 2; ++i) { int R, C; stage_rc(tid * 16 + i * 8192, R, C); const int Rb = Epi::PERM ? ((R & ~31) + perm32(R & 31)) : R;
        voffA[i] = (unsigned)(R * K + C) * 2u; voffB[i] = (unsigned)(Rb * K + C) * 2u; }
    const size_t kstep = (size_t)(BK * 2);
    const size_t hstep = (size_t)HALF * K * 2;
    const size_t tstep = 2 * hstep;
    const unsigned ldsw = (unsigned)wid * 1024u;
    const int aoff = lds_byte(wr * 64 + fr, fq * 8), boff = lds_byte(wc * 32 + fr, fq * 8);
#define PG8_SA(b, h) (((b) * 2 + (h)) * HTB)
#define PG8_SB(b, h) ((4 + (b) * 2 + (h)) * HTB)
#define PG8_STAGE(bufoff, gbase, voff) do { _Pragma("unroll") for (int _i = 0; _i < 2; ++_i) \
        __builtin_amdgcn_global_load_lds((const unsigned*)((const char*)(gbase) + (voff)[_i]), (PG8_LAS unsigned*)(lds + (bufoff) + ldsw + _i * 8192), 16, 0, 0); } while (0)
#define PG8_LDA(dst, b, h) do { _Pragma("unroll") for (int m = 0; m < 4; ++m) _Pragma("unroll") for (int k = 0; k < 2; ++k) dst[m][k] = *(const PG8_LAS bf16x8*)(lds + PG8_SA(b, h) + aoff + m * 2048 + k * 1024); } while (0)
#define PG8_LDB(dst, b, h) do { _Pragma("unroll") for (int n = 0; n < 2; ++n) _Pragma("unroll") for (int k = 0; k < 2; ++k) dst[n][k] = *(const PG8_LAS bf16x8*)(lds + PG8_SB(b, h) + boff + n * 2048 + k * 1024); } while (0)
#define PG8_MMA(ai, bj, At, Bt) do { __builtin_amdgcn_s_setprio(1); _Pragma("unroll") for (int m = 0; m < 4; ++m) _Pragma("unroll") for (int n = 0; n < 2; ++n) _Pragma("unroll") for (int k = 0; k < 2; ++k) \
        acc[ai][bj][m][n] = __builtin_amdgcn_mfma_f32_16x16x32_bf16(Bt[n][k], At[m][k], acc[ai][bj][m][n], 0, 0, 0); __builtin_amdgcn_s_setprio(0); } while (0)
#define PG8_WAIT_V(n) asm volatile("s_waitcnt vmcnt(" #n ")" ::: "memory")
#define PG8_WAIT_L(n) asm volatile("s_waitcnt lgkmcnt(" #n ")" ::: "memory")
#define PG8_BAR __builtin_amdgcn_s_barrier()
#define PG8_SCHED __builtin_amdgcn_sched_barrier(0)
    Unit cur, nxt; int ui = 0;
    if (!S.next(0, cur)) return;
    f32x4 acc[2][2][4][2];
#pragma unroll
    for (int a = 0; a < 2; ++a)
#pragma unroll
        for (int b = 0; b < 2; ++b)
#pragma unroll
            for (int m = 0; m < 4; ++m)
#pragma unroll
                for (int n = 0; n < 2; ++n) acc[a][b][m][n] = (f32x4){0.f, 0.f, 0.f, 0.f};
    bf16x8 At[4][2], B0[2][2], B1[2][2];
    const char* cA = (const char*)(cur.pn >= g.a2pn ? g.A2 : g.A) + (size_t)cur.pm * tstep; const char* cB = (const char*)g.Bt + (size_t)cur.pn * tstep;
    S.a_ready(cur);
    if constexpr (SP2) {
        PG8_STAGE(PG8_SB(0, 0), cB, voffB); PG8_STAGE(PG8_SB(0, 1), cB + hstep, voffB); PG8_STAGE(PG8_SA(0, 0), cA, voffA); PG8_STAGE(PG8_SA(0, 1), cA + hstep, voffA);
        if (wr == 1) PG8_BAR;
        PG8_WAIT_V(2); PG8_BAR;
        PG8_STAGE(PG8_SB(1, 0), cB + kstep, voffB); PG8_STAGE(PG8_SA(1, 0), cA + kstep, voffA); PG8_STAGE(PG8_SB(1, 1), cB + hstep + kstep, voffB);
        PG8_WAIT_V(6); PG8_BAR;
    } else {
        PG8_STAGE(PG8_SB(0, 0), cB, voffB); PG8_STAGE(PG8_SA(0, 0), cA, voffA); PG8_STAGE(PG8_SB(0, 1), cB + hstep, voffB); PG8_STAGE(PG8_SA(0, 1), cA + hstep, voffA);
        if (wr == 1) PG8_BAR;
        PG8_WAIT_V(4); PG8_BAR;
        PG8_STAGE(PG8_SB(1, 0), cB + kstep, voffB); PG8_STAGE(PG8_SA(1, 0), cA + kstep, voffA); PG8_STAGE(PG8_SB(1, 1), cB + hstep + kstep, voffB);
        PG8_WAIT_V(6); PG8_BAR;
    }
    for (;;) {
        const bool has_next = S.next(ui + 1, nxt);
        const char* nA = has_next ? (const char*)(nxt.pn >= g.a2pn ? g.A2 : g.A) + (size_t)nxt.pm * tstep : cA; const char* nB = has_next ? (const char*)g.Bt + (size_t)nxt.pn * tstep : cB;
        for (int t = 0; t < nt; t += 2) {
            const bool last = (t == nt - 2);
            const char* a1 = cA + (size_t)(t + 1) * kstep;
            const char* a2 = last ? nA : cA + (size_t)(t + 2) * kstep; const char* b2 = last ? nB : cB + (size_t)(t + 2) * kstep;
            const char* a3 = a2 + kstep; const char* b3 = b2 + kstep;
            if (last && has_next) S.a_ready(nxt);
            if constexpr (SP2) {
            PG8_LDB(B0, 0, 0); PG8_LDB(B1, 0, 1); PG8_SCHED; PG8_LDA(At, 0, 0); PG8_STAGE(PG8_SA(1, 1), a1 + hstep, voffA);
            PG8_WAIT_V(8); PG8_WAIT_L(0); PG8_BAR; PG8_MMA(0, 0, At, B0); PG8_MMA(0, 1, At, B1); PG8_BAR; PG8_SCHED;
            PG8_LDA(At, 0, 1); PG8_STAGE(PG8_SB(0, 0), b2, voffB); PG8_STAGE(PG8_SB(0, 1), b2 + hstep, voffB); PG8_STAGE(PG8_SA(0, 0), a2, voffA);
            PG8_WAIT_V(8); PG8_WAIT_L(0); PG8_BAR; PG8_MMA(1, 0, At, B0); PG8_MMA(1, 1, At, B1); PG8_BAR; PG8_SCHED;
            PG8_LDB(B0, 1, 0); PG8_LDB(B1, 1, 1); PG8_SCHED; PG8_LDA(At, 1, 0); PG8_STAGE(PG8_SA(0, 1), a2 + hstep, voffA);
            PG8_WAIT_V(8); PG8_WAIT_L(0); PG8_BAR; PG8_MMA(0, 0, At, B0); PG8_MMA(0, 1, At, B1); PG8_BAR; PG8_SCHED;
            PG8_LDA(At, 1, 1); PG8_STAGE(PG8_SB(1, 0), b3, voffB); PG8_STAGE(PG8_SB(1, 1), b3 + hstep, voffB); PG8_STAGE(PG8_SA(1, 0), a3, voffA);
            PG8_WAIT_V(8); PG8_WAIT_L(0); PG8_BAR; PG8_MMA(1, 0, At, B0); PG8_MMA(1, 1, At, B1); PG8_BAR; PG8_SCHED;
            } else {
            PG8_LDB(B0, 0, 0); PG8_SCHED; PG8_LDA(At, 0, 0); PG8_STAGE(PG8_SA(1, 1), a1 + hstep, voffA);
            PG8_WAIT_L(8); PG8_BAR; PG8_WAIT_L(0); PG8_MMA(0, 0, At, B0); PG8_BAR; PG8_SCHED;
            PG8_LDB(B1, 0, 1); PG8_STAGE(PG8_SB(0, 0), b2, voffB);
            PG8_BAR; PG8_WAIT_L(0); PG8_MMA(0, 1, At, B1); PG8_BAR;
            PG8_LDA(At, 0, 1); PG8_STAGE(PG8_SA(0, 0), a2, voffA);
            PG8_BAR; PG8_WAIT_L(0); PG8_MMA(1, 0, At, B0); PG8_BAR; PG8_SCHED;
            PG8_STAGE(PG8_SB(0, 1), b2 + hstep, voffB);
            PG8_WAIT_V(6); PG8_BAR; PG8_MMA(1, 1, At, B1); PG8_BAR;
            PG8_LDB(B0, 1, 0); PG8_SCHED; PG8_LDA(At, 1, 0); PG8_STAGE(PG8_SA(0, 1), a2 + hstep, voffA);
            PG8_WAIT_L(8); PG8_BAR; PG8_WAIT_L(0); PG8_MMA(0, 0, At, B0); PG8_BAR; PG8_SCHED;
            PG8_LDB(B1, 1, 1); PG8_STAGE(PG8_SB(1, 0), b3, voffB);
            PG8_BAR; PG8_WAIT_L(0); PG8_MMA(0, 1, At, B1); PG8_BAR;
            PG8_LDA(At, 1, 1); PG8_STAGE(PG8_SA(1, 0), a3, voffA);
            PG8_BAR; PG8_WAIT_L(0); PG8_MMA(1, 0, At, B0); PG8_BAR; PG8_SCHED;
            PG8_STAGE(PG8_SB(1, 1), b3 + hstep, voffB);
            PG8_WAIT_V(6); PG8_BAR; PG8_MMA(1, 1, At, B1); PG8_BAR;
            }
        }
        if constexpr (ALIGN_EPI) { if (wr == 0) PG8_BAR; }
        if constexpr (!Epi::AFTER_DRAIN) { E(acc, cur, wr, wc, fr, fq); S.done(cur); }
        if (!has_next) break;
#pragma unroll
        for (int a = 0; a < 2; ++a)
#pragma unroll
            for (int b = 0; b < 2; ++b)
#pragma unroll
                for (int m = 0; m < 4; ++m)
#pragma unroll
                    for (int n = 0; n < 2; ++n) acc[a][b][m][n] = (f32x4){0.f, 0.f, 0.f, 0.f};
        cur = nxt; cA = nA; cB = nB; ++ui;
        if constexpr (ALIGN_EPI) { if (wr == 1) PG8_BAR; }
    }
    PG8_WAIT_V(0);
    if constexpr (!ALIGN_EPI) { if (wr == 0) PG8_BAR; }
    PG8_BAR;
    if constexpr (Epi::AFTER_DRAIN) { E.fused(acc, cur, wr, wc, fr, fq, lds, wid, lane); S.done(cur); }
#undef PG8_SA
#undef PG8_SB
#undef PG8_STAGE
#undef PG8_LDA
#undef PG8_LDB
#undef PG8_MMA
#undef PG8_WAIT_V
#undef PG8_WAIT_L
#undef PG8_BAR
#undef PG8_SCHED
}
}

#define LAS __attribute__((address_space(3)))
using pg8::bf16_t; using pg8::bf16x8; using pg8::f32x4; using pg8::u32x4;
typedef float f32x16 __attribute__((ext_vector_type(16)));
typedef short s16x4 __attribute__((ext_vector_type(4)));
typedef unsigned u32x2 __attribute__((ext_vector_type(2)));
constexpr int MP = 32768, MS = 2048, M = MP + MS;
constexpr int D = 1024, FF = 2816, SEQ = 8192, DSEQ = 64, PAST = 1024;
constexpr float EPS = 1e-6f;
constexpr float C2 = 0.125f * 1.4426950408889634f;
constexpr size_t OKP = (size_t)M * D, OVP = OKP + (size_t)MP * D, OCP = OVP + (size_t)MP * D, OKS = OCP + 4 * 2 * D, OVS = OKS + (size_t)MS * D, OCS = OVS + (size_t)MS * D;
constexpr size_t MiB = 1u << 20;
constexpr size_t WS_SSQ = 0, WS_WGU1 = 1 * MiB, WS_WD1 = 12 * MiB, WS_WIN = 18 * MiB, WS_WAC = 34 * MiB, WS_WM = 38 * MiB, WS_WGU2 = 40 * MiB, WS_WD2 = 51 * MiB;
constexpr size_t WS_H = 60 * MiB, WS_HFF = 128 * MiB, WS_YRAW = 332 * MiB;
constexpr size_t WS_Q = 128 * MiB, WS_K = 196 * MiB, WS_V = 264 * MiB, WS_CB = 332 * MiB, WS_U = 400 * MiB, WS_END = 468 * MiB;
constexpr int LDS_BYTES = 163840;
constexpr size_t WS_BAR = 896 * 1024;
constexpr int LDS_MISC = 4 * 38912 + 256;

struct Params { const float* in[29]; float* out; unsigned char* ws; int nrep, pad; };

__device__ __forceinline__ unsigned pk2(float lo, float hi) { typedef float f2 __attribute__((ext_vector_type(2))); typedef __bf16 b2 __attribute__((ext_vector_type(2))); f2 v = {lo, hi}; b2 b = __builtin_convertvector(v, b2); return __builtin_bit_cast(unsigned, b); }
__device__ __forceinline__ float bf_lo(unsigned w) { return __uint_as_float(w << 16); }
__device__ __forceinline__ float bf_hi(unsigned w) { return __uint_as_float(w & 0xffff0000u); }
__device__ __forceinline__ u32x4 pack8(f32x4 a, f32x4 b) { u32x4 w; w.x = pk2(a[0], a[1]); w.y = pk2(a[2], a[3]); w.z = pk2(b[0], b[1]); w.w = pk2(b[2], b[3]); return w; }
__device__ __forceinline__ void unpack8(u32x4 w, f32x4& a, f32x4& b) { a = (f32x4){bf_lo(w.x), bf_hi(w.x), bf_lo(w.y), bf_hi(w.y)}; b = (f32x4){bf_lo(w.z), bf_hi(w.z), bf_lo(w.w), bf_hi(w.w)}; }
__device__ __forceinline__ float wave_sum(float v) {
#pragma unroll
    for (int o = 1; o < 64; o <<= 1) v += __shfl_xor(v, o);
    return v;
}
__device__ __forceinline__ float sigmoidf_fast(float x) { return __builtin_amdgcn_rcpf(1.f + __builtin_amdgcn_exp2f(-1.4426950409f * x)); }

struct EpiSwiGLU {
    static constexpr bool PERM = true, AFTER_DRAIN = false;
    bf16_t* O; const float* ssqx;
    __device__ __forceinline__ void operator()(const f32x4 (&acc)[2][2][4][2], const pg8::Unit& u, int wr, int wc, int fr, int fq) const {
        const int row0 = u.pm * 256 + wr * 64 + fr, col0 = u.pn * 128 + wc * 32 + 8 * fq;
#pragma unroll
        for (int ai = 0; ai < 2; ++ai)
#pragma unroll
            for (int m = 0; m < 4; ++m) {
                f32x4 v[2]; const float rs = rsqrtf(ssqx[row0 + ai * 128 + m * 16] * (1.f / D) + EPS);
#pragma unroll
                for (int n = 0; n < 2; ++n)
#pragma unroll
                    for (int i = 0; i < 4; ++i) { const float g = acc[ai][0][m][n][i] * rs; v[n][i] = g * sigmoidf_fast(g) * (acc[ai][1][m][n][i] * rs); }
                *(u32x4*)(O + (size_t)(row0 + ai * 128 + m * 16) * FF + col0) = pack8(v[0], v[1]);
            }
    }
};
struct EpiYSsq {
    static constexpr bool PERM = true, AFTER_DRAIN = false;
    bf16_t* Y; float* ssq;
    __device__ __forceinline__ void operator()(const f32x4 (&acc)[2][2][4][2], const pg8::Unit& u, int wr, int wc, int fr, int fq) const {
        const int row0 = u.pm * 256 + wr * 64 + fr, col0 = u.pn * 256 + wc * 32 + 8 * fq;
#pragma unroll
        for (int ai = 0; ai < 2; ++ai)
#pragma unroll
            for (int m = 0; m < 4; ++m) {
                const int row = row0 + ai * 128 + m * 16; float s = 0.f;
#pragma unroll
                for (int bj = 0; bj < 2; ++bj) { const f32x4 a = acc[ai][bj][m][0], b = acc[ai][bj][m][1];
                    s += (a[0] * a[0] + a[1] * a[1]) + (a[2] * a[2] + a[3] * a[3]) + (b[0] * b[0] + b[1] * b[1]) + (b[2] * b[2] + b[3] * b[3]);
                    *(u32x4*)(Y + (size_t)row * D + col0 + bj * 128) = pack8(a, b); }
                s += __shfl_xor(s, 16); s += __shfl_xor(s, 32);
                if (fq == 0) unsafeAtomicAdd(ssq + row, s);
            }
    }
};
struct EpiWin {
    static constexpr bool PERM = true, AFTER_DRAIN = false;
    bf16_t *Q, *Kb, *Vb, *CB, *U, *GA, *GB; float* out; const float* bgate; int pn_off; const float* ssqx;
    __device__ __forceinline__ void operator()(const f32x4 (&acc)[2][2][4][2], const pg8::Unit& u, int wr, int wc, int fr, int fq) const {
        const int pn = u.pn + pn_off, row0 = u.pm * 256 + wr * 64 + fr, cw = wc * 32 + 8 * fq;
        float rsv[2][4];
#pragma unroll
        for (int ai = 0; ai < 2; ++ai)
#pragma unroll
            for (int m = 0; m < 4; ++m) rsv[ai][m] = rsqrtf(ssqx[row0 + ai * 128 + m * 16] * (1.f / D) + EPS);
        if (pn < 4) {
#pragma unroll
            for (int ai = 0; ai < 2; ++ai)
#pragma unroll
                for (int m = 0; m < 4; ++m)
#pragma unroll
                    for (int bj = 0; bj < 2; ++bj)
                        *(u32x4*)(Q + (size_t)(row0 + ai * 128 + m * 16) * D + pn * 256 + bj * 128 + cw) = pack8(acc[ai][bj][m][0] * (C2 * rsv[ai][m]), acc[ai][bj][m][1] * (C2 * rsv[ai][m]));
        } else if (pn < 12) {
            const bool isv = pn >= 8; const int cb = (pn - (isv ? 8 : 4)) * 256 + cw;
            bf16_t* bd = isv ? Vb : Kb;
            float* od = (u.pm < MP / 256) ? out + (isv ? OVP : OKP) : out + (isv ? OVS : OKS) - (size_t)MP * D;
#pragma unroll
            for (int ai = 0; ai < 2; ++ai)
#pragma unroll
                for (int m = 0; m < 4; ++m)
#pragma unroll
                    for (int bj = 0; bj < 2; ++bj) { const size_t off = (size_t)(row0 + ai * 128 + m * 16) * D + cb + bj * 128;
                        const f32x4 a = acc[ai][bj][m][0] * rsv[ai][m], b = acc[ai][bj][m][1] * rsv[ai][m];
                        *(u32x4*)(bd + off) = pack8(a, b);
                        *(f32x4*)(od + off) = a; *(f32x4*)(od + off + 4) = b; }
        } else if (pn < 16) {
#pragma unroll
            for (int ai = 0; ai < 2; ++ai)
#pragma unroll
                for (int m = 0; m < 4; ++m)
#pragma unroll
                    for (int bj = 0; bj < 2; ++bj)
                        *(u32x4*)(CB + (size_t)(row0 + ai * 128 + m * 16) * D + (pn - 12) * 256 + bj * 128 + cw) = pack8(acc[ai][bj][m][0] * rsv[ai][m], acc[ai][bj][m][1] * rsv[ai][m]);
        } else if (pn < 24) {
#pragma unroll
            for (int ai = 0; ai < 2; ++ai)
#pragma unroll
                for (int m = 0; m < 4; ++m)
                    *(u32x4*)(U + (size_t)(row0 + ai * 128 + m * 16) * D + (pn - 16) * 128 + cw) = pack8(acc[ai][0][m][0] * acc[ai][1][m][0] * (rsv[ai][m] * rsv[ai][m]), acc[ai][0][m][1] * acc[ai][1][m][1] * (rsv[ai][m] * rsv[ai][m]));
        } else {
            const bool isb = pn >= 28; const int cb = (pn - (isb ? 28 : 24)) * 256 + cw;
            bf16_t* gd = isb ? GB : GA; const float* bias = bgate + (isb ? D : 0) + cb;
#pragma unroll
            for (int bj = 0; bj < 2; ++bj) { const f32x4 b0 = *(const f32x4*)(bias + bj * 128), b1 = *(const f32x4*)(bias + bj * 128 + 4);
#pragma unroll
                for (int ai = 0; ai < 2; ++ai)
#pragma unroll
                    for (int m = 0; m < 4; ++m) { f32x4 a = acc[ai][bj][m][0] * rsv[ai][m] + b0, b = acc[ai][bj][m][1] * rsv[ai][m] + b1;
#pragma unroll
                        for (int i = 0; i < 4; ++i) { a[i] = sigmoidf_fast(a[i]); b[i] = sigmoidf_fast(b[i]); }
                        *(u32x4*)(gd + (size_t)(row0 + ai * 128 + m * 16) * D + cb + bj * 128) = pack8(a, b); } }
        }
    }
};
struct EpiMerge {
    static constexpr bool PERM = true, AFTER_DRAIN = false;
    const bf16_t *GA, *GB; bf16_t* MRG;
    __device__ __forceinline__ void operator()(const f32x4 (&acc)[2][2][4][2], const pg8::Unit& u, int wr, int wc, int fr, int fq) const {
        const bool second = u.pn >= 4; const int row0 = u.pm * 256 + wr * 64 + fr, col0 = (u.pn & 3) * 256 + wc * 32 + 8 * fq;
        const bf16_t* G = second ? GB : GA;
#pragma unroll
        for (int ai = 0; ai < 2; ++ai)
#pragma unroll
            for (int m = 0; m < 4; ++m)
#pragma unroll
                for (int bj = 0; bj < 2; ++bj) { const size_t off = (size_t)(row0 + ai * 128 + m * 16) * D + col0 + bj * 128;
                    f32x4 g0, g1; unpack8(*(const u32x4*)(G + off), g0, g1);
                    f32x4 a = acc[ai][bj][m][0] * g0, b = acc[ai][bj][m][1] * g1;
                    if (second) { f32x4 p0, p1; unpack8(*(const u32x4*)(MRG + off), p0, p1); a += p0; b += p1; }
                    *(u32x4*)(MRG + off) = pack8(a, b); }
    }
};
struct PairOrder {
    int G, c, pm0, nL;
    __device__ bool next(int i, pg8::Unit& u) const { const int L = (i >> 1) * G + c; if (L >= nL) return false; u.pm = pm0 + (L >> 2); u.pn = (L & 3) + 4 * (i & 1); return true; }
    __device__ __forceinline__ void a_ready(const pg8::Unit&) const {}
    __device__ __forceinline__ void done(const pg8::Unit&) const {}
};
struct RangeOrder {
    pg8::StaticOrder S; int pm0;
    __device__ void init(int pm0_, int nM, int N, int G, int c) { S.init(nM * 256, N, G, c); pm0 = pm0_; }
    __device__ bool next(int i, pg8::Unit& u) const { if (!S.next(i, u)) return false; u.pm += pm0; return true; }
    __device__ __forceinline__ void a_ready(const pg8::Unit&) const {}
    __device__ __forceinline__ void done(const pg8::Unit&) const {}
};
struct SkipOrder {
    int G, c, ns, nL;
    __device__ bool next(int i, pg8::Unit& u) const {
        int L;
        if (G == 256 && nL == 512) { if (i == 0) L = c; else if (i == 1) { if (c < ns) return false; L = 256 + (c - ns); } else if (i == 2) { if (c < ns || c >= 2 * ns) return false; L = 512 - ns + (c - ns); } else return false; }
        else { L = i * G + c; if (L >= nL) return false; }
        u.pm = L >> 2; u.pn = L & 3; return true;
    }
    __device__ __forceinline__ void a_ready(const pg8::Unit&) const {}
    __device__ __forceinline__ void done(const pg8::Unit&) const {}
};

__device__ __forceinline__ void tr_item(const float* W, int ldw, int K, int ncols, bf16_t* WT, int mode, int row_off, const float* gk, LAS float* scr, int item, int lane) {
    const int nblk = ncols / 32, kb = item / nblk, nb = item % nblk, k0 = 64 * kb, n0 = 32 * nb;
#pragma unroll 8
    for (int i = 0; i < 32; ++i) { const int kk = 2 * i + (lane >> 5); scr[kk * 33 + (lane & 31)] = W[(size_t)(k0 + kk) * ldw + n0 + (lane & 31)] * (gk ? gk[k0 + kk] : 1.f); }
    asm volatile("s_waitcnt lgkmcnt(0)" ::: "memory");
    const int c = lane & 7, drow0 = row_off + (mode ? 256 * (n0 >> 7) + (n0 & 127) : n0);
#pragma unroll
    for (int j = 0; j < 4; ++j) { const int n = (lane >> 3) + 8 * j; const LAS float* s = scr + (8 * c) * 33 + n;
        u32x4 o; o.x = pk2(s[0 * 33], s[1 * 33]); o.y = pk2(s[2 * 33], s[3 * 33]); o.z = pk2(s[4 * 33], s[5 * 33]); o.w = pk2(s[6 * 33], s[7 * 33]);
        *(u32x4*)(WT + (size_t)(drow0 + n) * K + k0 + 8 * c) = o; }
    asm volatile("s_waitcnt lgkmcnt(0)" ::: "memory");
}
__device__ __forceinline__ const float* xrow_in(const Params& P, int r) { return r < MP ? P.in[0] + (size_t)r * D : P.in[1] + (size_t)(r - MP) * D; }

__device__ __forceinline__ void x0_rows(const Params& P, bf16_t* XB, float* ssqx, int gw, int NGW, int lane) {
    for (int r = gw; r < M; r += NGW) {
        const f32x4* xr = (const f32x4*)xrow_in(P, r); f32x4 v[4]; float s = 0.f;
#pragma unroll
        for (int j = 0; j < 4; ++j) { v[j] = xr[lane + 64 * j]; s += (v[j][0] * v[j][0] + v[j][1] * v[j][1]) + (v[j][2] * v[j][2] + v[j][3] * v[j][3]); }
        const float tot = wave_sum(s);
#pragma unroll
        for (int j = 0; j < 4; ++j) *(u32x2*)(XB + (size_t)r * D + (lane + 64 * j) * 4) = (u32x2){pk2(v[j][0], v[j][1]), pk2(v[j][2], v[j][3])};
        if (lane == 0) ssqx[r] = tot;
    }
}
template <bool FIRST, bool LAST>
__device__ __forceinline__ void ew_rows(const Params& P, const bf16_t* Y, const float* ssq, const float* gpost, float scale, bf16_t* XB, float* ssqx_out, int r_lo, int r_hi, int gw, int NGW, int lane) {
    for (int r = r_lo + gw; r < r_hi; r += NGW) {
        const float rs = rsqrtf(ssq[r] * (1.f / D) + EPS) * scale; float s = 0.f;
#pragma unroll
        for (int j = 0; j < 4; ++j) { const u32x2 yw = *(const u32x2*)(Y + (size_t)r * D + (lane + 64 * j) * 4); const f32x4 y = {bf_lo(yw.x), bf_hi(yw.x), bf_lo(yw.y), bf_hi(yw.y)};
            f32x4 xin;
            if (FIRST) xin = ((const f32x4*)xrow_in(P, r))[lane + 64 * j];
            else { const u32x2 xw = *(const u32x2*)(XB + (size_t)r * D + (lane + 64 * j) * 4); xin = (f32x4){bf_lo(xw.x), bf_hi(xw.x), bf_lo(xw.y), bf_hi(xw.y)}; }
            const f32x4 v = xin + y * rs * ((const f32x4*)gpost)[lane + 64 * j];
            if (LAST) ((f32x4*)(P.out + (size_t)r * D))[lane + 64 * j] = v;
            else { *(u32x2*)(XB + (size_t)r * D + (lane + 64 * j) * 4) = (u32x2){pk2(v[0], v[1]), pk2(v[2], v[3])}; s += (v[0] * v[0] + v[1] * v[1]) + (v[2] * v[2] + v[3] * v[3]); } }
        if (!LAST) { const float tot = wave_sum(s); if (lane == 0) ssqx_out[r] = tot; }
    }
}
__device__ __forceinline__ void conv_rows(const Params& P, bf16_t* CB, const bf16_t* U, int r_lo, int r_hi, int gw, int NGW, int lane) {
    const float* cw = P.in[20]; const float* cbias = P.in[21]; const float* st = P.in[4];
    for (int r = r_lo + gw; r < r_hi; r += NGW) {
        const bool samp = r >= MP; const int b = samp ? (r - MP) >> 6 : r >> 13, t = samp ? (r - MP) & 63 : r & 8191, T = samp ? DSEQ : SEQ;
#pragma unroll
        for (int jj = 0; jj < 2; ++jj) { const int c = (lane + 64 * jj) * 8;
            f32x4 u0a, u0b, u1a, u1b, u2a, u2b, ca, cb2; const f32x4 z4 = {0.f, 0.f, 0.f, 0.f};
            unpack8(*(const u32x4*)(U + (size_t)r * D + c), u0a, u0b);
            if (t >= 1) unpack8(*(const u32x4*)(U + (size_t)(r - 1) * D + c), u1a, u1b);
            else if (samp) { u1a = *(const f32x4*)(st + ((size_t)b * 2 + 1) * D + c); u1b = *(const f32x4*)(st + ((size_t)b * 2 + 1) * D + c + 4); } else { u1a = z4; u1b = z4; }
            if (t >= 2) unpack8(*(const u32x4*)(U + (size_t)(r - 2) * D + c), u2a, u2b);
            else if (samp) { u2a = *(const f32x4*)(st + ((size_t)b * 2 + t) * D + c); u2b = *(const f32x4*)(st + ((size_t)b * 2 + t) * D + c + 4); } else { u2a = z4; u2b = z4; }
            unpack8(*(const u32x4*)(CB + (size_t)r * D + c), ca, cb2);
            const f32x4 w0a = *(const f32x4*)(cw + c), w0b = *(const f32x4*)(cw + c + 4), w1a = *(const f32x4*)(cw + D + c), w1b = *(const f32x4*)(cw + D + c + 4), w2a = *(const f32x4*)(cw + 2 * D + c), w2b = *(const f32x4*)(cw + 2 * D + c + 4);
            const f32x4 ba = *(const f32x4*)(cbias + c), bb = *(const f32x4*)(cbias + c + 4);
            const f32x4 za = ba + w0a * u2a + w1a * u1a + w2a * u0a, zb = bb + w0b * u2b + w1b * u1b + w2b * u0b;
            *(u32x4*)(CB + (size_t)r * D + c) = pack8(ca * za, cb2 * zb);
            if (t >= T - 2) { float* o = P.out + (samp ? OCS : OCP) + ((size_t)b * 2 + (t - (T - 2))) * D + c; *(f32x4*)o = u0a; *(f32x4*)(o + 4) = u0b; }
        }
    }
}

constexpr int KROW = 144, VROW = 320, KBUF = 64 * KROW, STAGE = 2 * KBUF + 64 * VROW;
typedef short v4i16_t __attribute__((ext_vector_type(4)));
__device__ __forceinline__ s16x4 vtr(const LAS unsigned char* p) { return __builtin_bit_cast(s16x4, __builtin_amdgcn_ds_read_tr16_b64_v4i16((LAS v4i16_t*)p)); }
#define MFMA32(a, b, c) __builtin_amdgcn_mfma_f32_32x32x16_bf16((a), (b), (c), 0, 0, 0)
__device__ __forceinline__ void glds16(const void* gsrc, unsigned lds_dst) { unsigned keep;
    asm volatile("s_mov_b32 %0, m0\n\ts_mov_b32 m0, %2\n\ts_nop 0\n\tglobal_load_lds_dwordx4 %1, off\n\ts_mov_b32 m0, %0" : "=&s"(keep) : "v"(gsrc), "s"(lds_dst) : "memory"); }
__device__ __forceinline__ bf16x8 packp(const f32x16& p, int b) { u32x4 w; w.x = pk2(p[b], p[b + 1]); w.y = pk2(p[b + 2], p[b + 3]); w.z = pk2(p[b + 4], p[b + 5]); w.w = pk2(p[b + 6], p[b + 7]); return __builtin_bit_cast(bf16x8, w); }
#define SBAR() __builtin_amdgcn_sched_barrier(0)
__device__ __forceinline__ void attn_tile(const LAS unsigned char* st, int map, int lane, const bf16x8 (&qf)[4], f32x16 (&o)[4], f32x16& lsum, float& m_run, bool first) {
    const int r32 = lane & 31, hh = lane >> 5;
    const LAS unsigned char* kp = st + map * KBUF + r32 * KROW + hh * 16;
    const LAS unsigned char* vp = st + 2 * KBUF + (4 * hh + ((lane & 15) >> 2)) * VROW + 32 * ((lane >> 4) & 1) + 8 * (lane & 3);
    f32x16 p0, p1;
    { const float nm = -m_run;
#pragma unroll
      for (int i = 0; i < 16; ++i) { p0[i] = nm; p1[i] = nm; } }
    bf16x8 kf[8]; s16x4 vlo[2][4], vhi[2][4];
    SBAR();
#pragma unroll
    for (int ds = 0; ds < 4; ++ds) { kf[2 * ds] = *(const LAS bf16x8*)(kp + ds * 32); kf[2 * ds + 1] = *(const LAS bf16x8*)(kp + 32 * KROW + ds * 32); }
#pragma unroll
    for (int d = 0; d < 4; ++d) { vlo[0][d] = vtr(vp + d * 64); vhi[0][d] = vtr(vp + 8 * VROW + d * 64); }
    SBAR();
#pragma unroll
    for (int ds = 0; ds < 4; ++ds) { p0 = MFMA32(kf[2 * ds], qf[ds], p0); p1 = MFMA32(kf[2 * ds + 1], qf[ds], p1); }
    SBAR();
    f32x16 e0, e1;
#pragma unroll
    for (int i = 0; i < 16; ++i) { e0[i] = __builtin_amdgcn_exp2f(p0[i]); e1[i] = __builtin_amdgcn_exp2f(p1[i]); }
    float mt = fmaxf(fmaxf(e0[0], e1[0]), e0[1]);
#pragma unroll
    for (int i = 1; i < 16; ++i) mt = (i == 1) ? fmaxf(mt, e1[1]) : fmaxf(fmaxf(mt, e0[i]), e1[i]);
    { auto rr = __builtin_amdgcn_permlane32_swap(__float_as_uint(mt), __float_as_uint(mt), false, false); mt = fmaxf(__uint_as_float(rr[0]), __uint_as_float(rr[1])); }
    if (first || __any(!(mt <= 256.f))) {
        float rm = fmaxf(p0[0], p1[0]);
#pragma unroll
        for (int i = 1; i < 16; ++i) rm = fmaxf(rm, fmaxf(p0[i], p1[i]));
        { auto rr = __builtin_amdgcn_permlane32_swap(__float_as_uint(rm), __float_as_uint(rm), false, false); rm = fmaxf(__uint_as_float(rr[0]), __uint_as_float(rr[1])); }
        const float dl = first ? rm : fmaxf(rm, 0.f);
        m_run += dl;
#pragma unroll
        for (int i = 0; i < 16; ++i) { e0[i] = __builtin_amdgcn_exp2f(p0[i] - dl); e1[i] = __builtin_amdgcn_exp2f(p1[i] - dl); }
        if (!first) { const float a = __builtin_amdgcn_exp2f(-dl);
#pragma unroll
            for (int i = 0; i < 16; ++i) lsum[i] *= a;
#pragma unroll
            for (int d = 0; d < 4; ++d)
#pragma unroll
                for (int i = 0; i < 16; ++i) o[d][i] *= a; }
    }
    bf16x8 pf[4]; pf[0] = packp(e0, 0); pf[1] = packp(e0, 8); pf[2] = packp(e1, 0); pf[3] = packp(e1, 8);
    const bf16x8 ones = {(short)0x3F80, (short)0x3F80, (short)0x3F80, (short)0x3F80, (short)0x3F80, (short)0x3F80, (short)0x3F80, (short)0x3F80};
    SBAR();
#pragma unroll
    for (int ks = 0; ks < 4; ++ks) {
        if (ks < 3) {
#pragma unroll
            for (int d = 0; d < 4; ++d) { vlo[(ks + 1) & 1][d] = vtr(vp + (ks + 1) * 16 * VROW + d * 64); vhi[(ks + 1) & 1][d] = vtr(vp + (ks + 1) * 16 * VROW + 8 * VROW + d * 64); }
            SBAR();
        }
#pragma unroll
        for (int d = 0; d < 4; ++d) { const bf16x8 a = __builtin_shufflevector(vlo[ks & 1][d], vhi[ks & 1][d], 0, 1, 2, 3, 4, 5, 6, 7); o[d] = MFMA32(a, pf[ks], o[d]); }
        lsum = MFMA32(ones, pf[ks], lsum);
        SBAR();
    }
}
__device__ __forceinline__ void attn_qk(const LAS unsigned char* st, int map, int lane, const bf16x8 (&qf)[4], float m_run, f32x16& p0, f32x16& p1,
                                        bool do_dma, const bf16_t* const (&src)[5], const unsigned (&dsto)[5], unsigned ldsb, size_t toff) {
    const int r32 = lane & 31, hh = lane >> 5;
    const LAS unsigned char* kp = st + map * KBUF + r32 * KROW + hh * 16;
    { const float nm = -m_run;
#pragma unroll
      for (int i = 0; i < 16; ++i) { p0[i] = nm; p1[i] = nm; } }
    bf16x8 kf[8];
    SBAR();
#pragma unroll
    for (int ds = 0; ds < 4; ++ds) { kf[2 * ds] = *(const LAS bf16x8*)(kp + ds * 32); kf[2 * ds + 1] = *(const LAS bf16x8*)(kp + 32 * KROW + ds * 32); }
    SBAR();
#pragma unroll
    for (int k = 0; k < 8; ++k) {
        if (k & 1) p1 = MFMA32(kf[k], qf[k >> 1], p1); else p0 = MFMA32(kf[k], qf[k >> 1], p0);
        if (k < 5) { if (do_dma) glds16(src[k] + toff, (unsigned)__builtin_amdgcn_readfirstlane(ldsb + dsto[k])); }
        SBAR();
    }
}
template <bool PV>
__device__ __forceinline__ void attn_exp_pv(const LAS unsigned char* stv, int lane, const bf16x8 (&pf)[4], f32x16 (&o)[4], f32x16& lsum, const f32x16& p0, const f32x16& p1, f32x16& e0, f32x16& e1, float& mt) {
    const int hh = lane >> 5;
    const LAS unsigned char* vp = stv + 2 * KBUF + (4 * hh + ((lane & 15) >> 2)) * VROW + 32 * ((lane >> 4) & 1) + 8 * (lane & 3);
    const bf16x8 ones = {(short)0x3F80, (short)0x3F80, (short)0x3F80, (short)0x3F80, (short)0x3F80, (short)0x3F80, (short)0x3F80, (short)0x3F80};
    SBAR();
    if (PV) {
        s16x4 vlo[2][4], vhi[2][4];
#pragma unroll
        for (int d = 0; d < 4; ++d) { vlo[0][d] = vtr(vp + d * 64); vhi[0][d] = vtr(vp + 8 * VROW + d * 64); }
        SBAR();
#pragma unroll
        for (int ks = 0; ks < 4; ++ks) {
            if (ks < 3) {
#pragma unroll
                for (int d = 0; d < 4; ++d) { vlo[(ks + 1) & 1][d] = vtr(vp + (ks + 1) * 16 * VROW + d * 64); vhi[(ks + 1) & 1][d] = vtr(vp + (ks + 1) * 16 * VROW + 8 * VROW + d * 64); }
                SBAR();
            }
#pragma unroll
            for (int d = 0; d < 5; ++d) {
                if (d < 4) { const bf16x8 a = __builtin_shufflevector(vlo[ks & 1][d], vhi[ks & 1][d], 0, 1, 2, 3, 4, 5, 6, 7); o[d] = MFMA32(a, pf[ks], o[d]); }
                else lsum = MFMA32(ones, pf[ks], lsum);
                const int g = ks * 5 + d;
                if (g < 16) { e0[g] = __builtin_amdgcn_exp2f(p0[g]); e1[g] = __builtin_amdgcn_exp2f(p1[g]); }
                else {
#pragma unroll
                    for (int i = 4 * (g - 16); i < 4 * (g - 16) + 4; ++i) mt = (i == 0) ? fmaxf(e0[0], e1[0]) : fmaxf(fmaxf(mt, e0[i]), e1[i]);
                }
                SBAR();
            }
        }
    } else {
#pragma unroll
        for (int i = 0; i < 16; ++i) { e0[i] = __builtin_amdgcn_exp2f(p0[i]); e1[i] = __builtin_amdgcn_exp2f(p1[i]); }
        mt = fmaxf(e0[0], e1[0]);
#pragma unroll
        for (int i = 1; i < 16; ++i) mt = fmaxf(fmaxf(mt, e0[i]), e1[i]);
    }
    SBAR();
}
__device__ __forceinline__ void attn_decide_pack(const f32x16& p0, const f32x16& p1, f32x16& e0, f32x16& e1, float mt, f32x16 (&o)[4], f32x16& lsum, float& m_run, bool first, bf16x8 (&pf)[4]) {
    { auto rr = __builtin_amdgcn_permlane32_swap(__float_as_uint(mt), __float_as_uint(mt), false, false); mt = fmaxf(__uint_as_float(rr[0]), __uint_as_float(rr[1])); }
    if (first || __any(!(mt <= 256.f))) {
        float rm = fmaxf(p0[0], p1[0]);
#pragma unroll
        for (int i = 1; i < 16; ++i) rm = fmaxf(rm, fmaxf(p0[i], p1[i]));
        { auto rr = __builtin_amdgcn_permlane32_swap(__float_as_uint(rm), __float_as_uint(rm), false, false); rm = fmaxf(__uint_as_float(rr[0]), __uint_as_float(rr[1])); }
        const float dl = first ? rm : fmaxf(rm, 0.f);
        m_run += dl;
#pragma unroll
        for (int i = 0; i < 16; ++i) { e0[i] = __builtin_amdgcn_exp2f(p0[i] - dl); e1[i] = __builtin_amdgcn_exp2f(p1[i] - dl); }
        if (!first) { const float a = __builtin_amdgcn_exp2f(-dl);
#pragma unroll
            for (int i = 0; i < 16; ++i) lsum[i] *= a;
#pragma unroll
            for (int d = 0; d < 4; ++d)
#pragma unroll
                for (int i = 0; i < 16; ++i) o[d][i] *= a; }
    }
    pf[0] = packp(e0, 0); pf[1] = packp(e0, 8); pf[2] = packp(e1, 0); pf[3] = packp(e1, 8);
}
template <bool SAMPLE>
__device__ __forceinline__ void attn_unit(LAS unsigned char* L, const bf16_t* Qb, const bf16_t* Kb, const bf16_t* Vb, bf16_t* Ob, const float* cK, const float* cV,
                                          size_t qrow0, size_t kvrow0, int head, int NT, float lam, const float* subg, bool do_store) {
    int tid_l = threadIdx.x; asm volatile("" : "+v"(tid_l));
    const int tid = tid_l, lane = tid & 63, r32 = lane & 31, hh = lane >> 5;
    const int wid = __builtin_amdgcn_readfirstlane(tid >> 6), map = wid >> 2, qg = wid & 3;
    const bool active = SAMPLE ? (qg < 2) : true;
    const int nvis = SAMPLE ? NT : ((qg < 2) ? NT - 1 : NT);
    bf16x8 qf[4];
    { const bf16_t* qp = Qb + (qrow0 + (active ? qg * 32 + r32 : 0)) * D + head * 128 + map * 64 + hh * 8;
#pragma unroll
      for (int ds = 0; ds < 4; ++ds) qf[ds] = *(const bf16x8*)(qp + ds * 16); }
    asm volatile("" : "+v"(qf[0]), "+v"(qf[1]), "+v"(qf[2]), "+v"(qf[3]));
    f32x16 o[4];
#pragma unroll
    for (int d = 0; d < 4; ++d)
#pragma unroll
        for (int i = 0; i < 16; ++i) o[d][i] = 0.f;
    float m_run = 0.f; f32x16 lsum;
#pragma unroll
    for (int i = 0; i < 16; ++i) lsum[i] = 0.f;
    const int skey = tid >> 4, sch = tid & 15;
    const size_t gofs = (size_t)skey * D + head * 128 + sch * 8;
    const int dK = (sch >> 3) * KBUF + skey * KROW + (sch & 7) * 16, dV = 2 * KBUF + skey * VROW + sch * 16;
    if (!SAMPLE) {
        const bf16_t* src[5]; unsigned dsto[5];
#pragma unroll
        for (int j = 0; j < 5; ++j) { int p = wid + 8 * j; if (p > 37) p -= 2; const int c = 64 * p + lane; dsto[j] = (unsigned)p * 1024u;
            if (p < 18) { const int mp = c / 576, rc = c - mp * 576, row = rc / 9; int col = rc - row * 9; if (col == 8) col = 0; src[j] = Kb + (kvrow0 + row) * D + head * 128 + mp * 64 + col * 8; }
            else { const int c2 = c - 1152, row = c2 / 20, col = (c2 - row * 20) & 15; src[j] = Vb + (kvrow0 + row) * D + head * 128 + col * 8; } }
        const unsigned lds0 = (unsigned)(uintptr_t)L;
#define AT_DMA(t, sb) do { _Pragma("unroll") for (int j_ = 0; j_ < 5; ++j_) glds16(src[j_] + (size_t)(t) * 64 * D, (unsigned)__builtin_amdgcn_readfirstlane(lds0 + (sb) + dsto[j_])); } while (0)
        bf16x8 pf[4]; f32x16 p0, p1, e0, e1; float mt;
        AT_DMA(0, 0); AT_DMA(1, STAGE);
        asm volatile("s_waitcnt vmcnt(5) lgkmcnt(0)\n\ts_barrier" ::: "memory");
        for (int t = 0; t < NT; ++t) {
            if (t < nvis) {
                attn_qk(L + (t & 3) * STAGE, map, lane, qf, m_run, p0, p1, t + 2 < NT, src, dsto, lds0 + ((t + 2) & 3) * STAGE, (size_t)(t + 2) * 64 * D);
                if (t == 0) attn_exp_pv<false>(L, lane, pf, o, lsum, p0, p1, e0, e1, mt);
                else attn_exp_pv<true>(L + ((t - 1) & 3) * STAGE, lane, pf, o, lsum, p0, p1, e0, e1, mt);
                attn_decide_pack(p0, p1, e0, e1, mt, o, lsum, m_run, t == 0, pf);
            }
            if (t + 2 < NT) asm volatile("s_waitcnt vmcnt(5) lgkmcnt(0)\n\ts_barrier" ::: "memory");
            else asm volatile("s_waitcnt vmcnt(0) lgkmcnt(0)\n\ts_barrier" ::: "memory");
        }
        { f32x16 z0 = p0, z1 = p1; float mt2;
          attn_exp_pv<true>(L + ((nvis - 1) & 3) * STAGE, lane, pf, o, lsum, z0, z1, e0, e1, mt2); }
        __syncthreads();
    } else {
        const int key = tid >> 5, f4 = tid & 31;
        f32x4 fk[4], fv[4];
#define AT_LOADF(t) do { _Pragma("unroll") for (int i_ = 0; i_ < 4; ++i_) { const size_t src_ = ((size_t)((t) * 64 + key + 16 * i_) * 8 + head) * 128 + f4 * 4; fk[i_] = *(const f32x4*)(cK + src_); fv[i_] = *(const f32x4*)(cV + src_); } } while (0)
        AT_LOADF(0);
        for (int t = 0; t < NT; ++t) {
            LAS unsigned char* s_ = L + (t & 1) * STAGE;
            if (t < PAST / 64) {
#pragma unroll
                for (int i = 0; i < 4; ++i) {
                    *(LAS u32x2*)(s_ + (f4 >> 4) * KBUF + (key + 16 * i) * KROW + (f4 & 15) * 8) = (u32x2){pk2(fk[i][0], fk[i][1]), pk2(fk[i][2], fk[i][3])};
                    *(LAS u32x2*)(s_ + 2 * KBUF + (key + 16 * i) * VROW + f4 * 8) = (u32x2){pk2(fv[i][0], fv[i][1]), pk2(fv[i][2], fv[i][3])}; }
            } else {
                u32x4 rk0, rk1, rv0, rv1;
                { const bf16_t* kp_ = Kb + qrow0 * D + gofs; const bf16_t* vp_ = Vb + qrow0 * D + gofs;
                  rk0 = *(const u32x4*)kp_; rk1 = *(const u32x4*)(kp_ + 32 * D); rv0 = *(const u32x4*)vp_; rv1 = *(const u32x4*)(vp_ + 32 * D); }
                *(LAS u32x4*)(s_ + dK) = rk0; *(LAS u32x4*)(s_ + dK + 32 * KROW) = rk1; *(LAS u32x4*)(s_ + dV) = rv0; *(LAS u32x4*)(s_ + dV + 32 * VROW) = rv1;
            }
            __syncthreads();
            if (t + 1 < PAST / 64) AT_LOADF(t + 1);
            if (active) attn_tile(s_, map, lane, qf, o, lsum, m_run, t == 0);
        }
        __syncthreads();
    }
    const float inv = active ? 1.f / lsum[0] : 0.f;
    LAS float* X = (LAS float*)L;
    if (active && map == 1) {
#pragma unroll
        for (int d = 0; d < 4; ++d)
#pragma unroll
            for (int i = 0; i < 16; ++i) X[((qg * 4 + d) * 16 + i) * 64 + lane] = o[d][i] * inv;
    }
    __syncthreads();
    if (active && map == 0 && do_store) {
        float ss = 0.f;
#pragma unroll
        for (int d = 0; d < 4; ++d)
#pragma unroll
            for (int i = 0; i < 16; ++i) { const float v = o[d][i] * inv - lam * X[((qg * 4 + d) * 16 + i) * 64 + lane]; o[d][i] = v; ss += v * v; }
        ss += __shfl_xor(ss, 32);
        const float rs = rsqrtf(ss * (1.f / 128.f) + EPS) * 0.8f;
        bf16_t* op = Ob + (qrow0 + qg * 32 + r32) * D + head * 128 + 4 * hh;
#pragma unroll
        for (int d = 0; d < 4; ++d)
#pragma unroll
            for (int g4 = 0; g4 < 4; ++g4) { const f32x4 gg = *(const f32x4*)(subg + 32 * d + 8 * g4 + 4 * hh);
                *(u32x2*)(op + 32 * d + 8 * g4) = (u32x2){pk2(o[d][4 * g4] * rs * gg[0], o[d][4 * g4 + 1] * rs * gg[1]), pk2(o[d][4 * g4 + 2] * rs * gg[2], o[d][4 * g4 + 3] * rs * gg[3])}; }
    }
    __syncthreads();
}

#define XB_TMO      128
#define XB_XCNT(j)  (256  + 64 * (j))
#define XB_XSUB(j)  (1280 + 64 * (j))
#define XB_XGEN(j)  (2304 + 64 * (j))
#define XB_TOP      3328
#define XB_TOPGEN   3392
#define XCD_BAR_WORDS 3456
#define XB_SPIN_CAP (1u << 18)

__device__ __forceinline__ unsigned xb_ld(unsigned* p)              { return __hip_atomic_load(p, __ATOMIC_RELAXED, __HIP_MEMORY_SCOPE_AGENT); }
__device__ __forceinline__ unsigned xb_add(unsigned* p, unsigned v) { return __hip_atomic_fetch_add(p, v, __ATOMIC_RELAXED, __HIP_MEMORY_SCOPE_AGENT); }
__device__ __forceinline__ unsigned xb_xcc_id() { return (unsigned)__builtin_amdgcn_s_getreg((3 << 11) | 20) & 0xFu; }
#define XB_SPIN(cond, bar) do { unsigned _sp = 0; while (cond) { __builtin_amdgcn_s_sleep(1); \
    if ((++_sp & 255u) == 0u) { if (xb_ld(&(bar)[XB_TMO])) break; if (_sp > XB_SPIN_CAP) { atomicAdd(&(bar)[XB_TMO], 1u); break; } } } } while (0)

struct XcdBarrier {
    unsigned* bar; unsigned x;
    volatile LAS unsigned* st;
};

__device__ __forceinline__ XcdBarrier xcd_barrier_post(unsigned* bar, volatile LAS unsigned* st) {
    XcdBarrier b; b.bar = bar; b.x = xb_xcc_id(); b.st = st;
    if (threadIdx.x == 0) (void)xb_add(&bar[XB_XCNT(b.x)], 1u);
    return b;
}
__device__ __forceinline__ void xcd_barrier_complete(unsigned* bar, unsigned x, unsigned& nloc, unsigned& nx) {
    const unsigned G = gridDim.x * gridDim.y * gridDim.z;
    unsigned sum, cnt, mine, sp = 0u;
    for (;;) {
        sum = 0u; cnt = 0u; mine = 0u;
#pragma unroll
        for (unsigned j = 0; j < 16; ++j) { const unsigned c = xb_ld(&bar[XB_XCNT(j)]); sum += c; cnt += (c > 0u) ? 1u : 0u; mine = (j == x) ? c : mine; }
        if (sum == G) break;
        __builtin_amdgcn_s_sleep(1);
        if ((++sp & 255u) == 0u) { if (xb_ld(&bar[XB_TMO])) break; if (sp > XB_SPIN_CAP) { atomicAdd(&bar[XB_TMO], 1u); break; } }
    }
    nloc = mine > 0u ? mine : 1u; nx = cnt > 0u ? cnt : 1u;
}

__device__ __forceinline__ void xcd_barrier(const XcdBarrier& b) {
    asm volatile("s_waitcnt vmcnt(0)" ::: "memory");
    __syncthreads();
    if (threadIdx.x == 0) {
        unsigned* bar = b.bar;
        __builtin_amdgcn_s_waitcnt(0);
        unsigned nloc = b.st[0], nx = b.st[1];
        if (nloc == 0u) { xcd_barrier_complete(bar, b.x, nloc, nx); b.st[0] = nloc; b.st[1] = nx; }
        const unsigned old = xb_add(&bar[XB_XSUB(b.x)], 1u);
        const unsigned gen = old / nloc;
        if (old + 1u == (gen + 1u) * nloc) {
            __builtin_amdgcn_fence(__ATOMIC_RELEASE, "agent");
            asm volatile("s_waitcnt vmcnt(0)" ::: "memory");
            const unsigned og = xb_add(&bar[XB_TOP], 1u);
            const unsigned tg = og / nx;
            if (og + 1u == (tg + 1u) * nx) xb_add(&bar[XB_TOPGEN], 1u);
            else XB_SPIN(xb_ld(&bar[XB_TOPGEN]) == tg, bar);
            __builtin_amdgcn_fence(__ATOMIC_ACQUIRE, "agent");
            xb_add(&bar[XB_XGEN(b.x)], 1u);
            asm volatile("s_waitcnt vmcnt(0)" ::: "memory");
        } else {
            XB_SPIN(xb_ld(&bar[XB_XGEN(b.x)]) == gen, bar);
            __builtin_amdgcn_fence(__ATOMIC_ACQUIRE, "agent");
            asm volatile("s_waitcnt vmcnt(0)" ::: "memory");
        }
    }
    __syncthreads();
}

#define GEMM_PHASE(EPI, SCHED, g, S, E) pg8::gemm_phase<EPI, SCHED, true, true>(Lds, g, S, E)
__global__ void __launch_bounds__(512, 2) mk_fwd(Params P) {
    extern __shared__ __attribute__((aligned(16))) unsigned char lds[];
    cg::grid_group grid = cg::this_grid();
    LAS unsigned char* Lds = (LAS unsigned char*)lds;
    const int tid = threadIdx.x, lane = tid & 63, wave = __builtin_amdgcn_readfirstlane(tid >> 6);
    const int G = gridDim.x, bid = blockIdx.x, gw = bid * 8 + wave, NGW = G * 8;
    unsigned char* ws = P.ws;
    float* ssq = (float*)(ws + WS_SSQ); float* ssqx = ssq + 3 * M;
    if (tid < 8) ((LAS unsigned*)(Lds + LDS_MISC))[tid] = 0u;
    __syncthreads();
    const XcdBarrier xbar = xcd_barrier_post((unsigned*)(ws + WS_BAR), (volatile LAS unsigned*)(Lds + LDS_MISC));
    bf16_t *WGU1 = (bf16_t*)(ws + WS_WGU1), *WD1 = (bf16_t*)(ws + WS_WD1), *WIN = (bf16_t*)(ws + WS_WIN), *WAC = (bf16_t*)(ws + WS_WAC), *WM = (bf16_t*)(ws + WS_WM), *WGU2 = (bf16_t*)(ws + WS_WGU2), *WD2 = (bf16_t*)(ws + WS_WD2);
    bf16_t *H = (bf16_t*)(ws + WS_H), *HFF = (bf16_t*)(ws + WS_HFF), *YRAW = (bf16_t*)(ws + WS_YRAW);
    bf16_t *Qb = (bf16_t*)(ws + WS_Q), *Kb = (bf16_t*)(ws + WS_K), *Vb = (bf16_t*)(ws + WS_V), *CB = (bf16_t*)(ws + WS_CB), *U = (bf16_t*)(ws + WS_U);
    bf16_t *GA = Kb, *GB = Vb, *MRG = U;
    bf16_t *GAs = (bf16_t*)(ws + WS_END) - (size_t)MP * D, *GBs = GAs + (size_t)MS * D;

    {
        LAS float* scr = (LAS float*)(Lds + wave * 16384);
        constexpr int I_GU = 16 * 88, I_DN = 44 * 32, I_W4 = 16 * 128, I_1K = 16 * 32, I_2K = 16 * 64;
        constexpr int NITEMS = 6 * I_GU + I_W4 + 2 * I_1K + I_2K + 3 * I_1K;
        for (int it = gw; it < NITEMS; it += NGW) {
            int r = it;
#define TR(cnt, W, ldw, K, nc, WT, mode, off, gk) if (r < (cnt)) { tr_item(W, ldw, K, nc, WT, mode, off, gk, scr, r, lane); continue; } r -= (cnt);
            TR(I_GU, P.in[7], FF, D, FF, WGU1, 1, 0, P.in[5])
            TR(I_GU, P.in[8], FF, D, FF, WGU1, 1, 128, P.in[5])
            TR(I_DN, P.in[9], D, FF, D, WD1, 0, 0, nullptr)
            TR(I_GU, P.in[26], FF, D, FF, WGU2, 1, 0, P.in[24])
            TR(I_GU, P.in[27], FF, D, FF, WGU2, 1, 128, P.in[24])
            TR(I_DN, P.in[28], D, FF, D, WD2, 0, 0, nullptr)
            TR(I_W4, P.in[12], 8192, D, 4096, WIN, 0, 0, P.in[10])
            TR(I_1K, P.in[12] + 4096, 8192, D, 1024, WIN, 1, 4096, P.in[10])
            TR(I_1K, P.in[12] + 5120, 8192, D, 1024, WIN, 1, 4096 + 128, P.in[10])
            TR(I_2K, P.in[12] + 6144, 8192, D, 2048, WIN, 0, 6144, P.in[10])
            TR(I_1K, P.in[19], D, D, D, WAC, 0, 0, nullptr)
            TR(I_1K, P.in[22], D, D, D, WAC, 0, 1024, nullptr)
            TR(I_1K, P.in[23], D, D, D, WM, 0, 0, nullptr)
#undef TR
        }
        for (int i = bid * 512 + tid; i < 3 * M; i += G * 512) ssq[i] = 0.f;
        x0_rows(P, H, ssqx, gw, NGW, lane);
    }
    float lam;
    { const float d1 = wave_sum(P.in[14][lane] * P.in[15][lane]), d2 = wave_sum(P.in[16][lane] * P.in[17][lane]); lam = expf(d1) - expf(d2) + 0.2f; }
    if (P.pad == 0x7ead) grid.sync();
    xcd_barrier(xbar);
    constexpr int PMP = MP / 256, PMS = MS / 256;
    const int ns = 32; const bool split = G >= 4 * ns;
    const int gwE = split ? (bid - ns) * 8 + wave : gw, NGWE = split ? (G - ns) * 8 : NGW;
    const bool doG = !split || bid < ns, doE = !split || bid >= ns; const int Gs = split ? ns : G;
#define GEMM_RC(EPI, A_, B_, N_, K_, pm0_, nM_, G_, c_, ...) do { pg8::Gemm g_{A_, B_, M, N_, K_, A_, 1 << 30}; RangeOrder S_; S_.init(pm0_, nM_, N_, G_, c_); EPI E_{__VA_ARGS__}; GEMM_PHASE(EPI, RangeOrder, g_, S_, E_); } while (0)
#define GEMM_R(EPI, A_, B_, N_, K_, pm0_, nM_, G_, ...) GEMM_RC(EPI, A_, B_, N_, K_, pm0_, nM_, G_, bid, __VA_ARGS__)
    GEMM_R(EpiSwiGLU, H, WGU1, 2 * FF, D, 0, PMP, G, HFF, ssqx);
    xcd_barrier(xbar);
    GEMM_R(EpiYSsq, HFF, WD1, D, FF, 0, PMP, G, YRAW, ssq);
    GEMM_R(EpiSwiGLU, H, WGU1, 2 * FF, D, PMP, PMS, G, HFF, ssqx);
    xcd_barrier(xbar);
    if (doG) GEMM_R(EpiYSsq, HFF, WD1, D, FF, PMP, PMS, Gs, YRAW, ssq);
    if (doE) ew_rows<true, false>(P, YRAW, ssq, P.in[6], 0.5f, H, ssqx + M, 0, MP, gwE, NGWE, lane);
    xcd_barrier(xbar);
    ew_rows<true, false>(P, YRAW, ssq, P.in[6], 0.5f, H, ssqx + M, MP, M, gw, NGW, lane);
    GEMM_R(EpiWin, H, WIN, 6144, D, 0, PMP, G, Qb, Kb, Vb, CB, U, GA, GB, P.out, P.in[13], 0, ssqx + M);
    xcd_barrier(xbar);
    conv_rows(P, CB, U, 0, MP, gw, NGW, lane);
    for (int k = bid * 2; k < 2048; k += 2 * G) {
        for (int half = 0; half < 2; ++half) {
            const int pu = k >> 1, x = pu & 7, j = (pu >> 3) & 31, i = pu >> 8, bh = x + 8 * i, b = bh >> 3, hd = bh & 7, qblk = half ? 63 - j : j;
            attn_unit<false>(Lds, Qb, Kb, Vb, Qb, nullptr, nullptr, (size_t)b * SEQ + (size_t)qblk * 128, (size_t)b * SEQ, hd, 2 * qblk + 2, lam, P.in[18], true);
        }
    }
    GEMM_R(EpiWin, H, WIN, 6144, D, PMP, PMS, G, Qb, Kb, Vb, CB, U, GA, GB, P.out, P.in[13], 0, ssqx + M);
    GEMM_RC(EpiWin, H, WIN + (size_t)6144 * D, 2048, D, PMP, PMS, G, (bid + PMS * 8) % G, Qb, Kb, Vb, CB, U, GAs, GBs, P.out, P.in[13], 24, ssqx + M);
    xcd_barrier(xbar);
    GEMM_R(EpiWin, H, WIN + (size_t)6144 * D, 2048, D, 0, PMP, G, Qb, Kb, Vb, CB, U, GA, GB, P.out, P.in[13], 24, ssqx + M);
    conv_rows(P, CB, U, MP, M, gw, NGW, lane);
    for (int su = bid; su < 256; su += G) {
        const int b = su >> 3, hd = su & 7;
        attn_unit<true>(Lds, Qb, Kb, Vb, Qb, P.in[2] + (size_t)b * PAST * D, P.in[3] + (size_t)b * PAST * D, (size_t)MP + (size_t)b * DSEQ, 0, hd, PAST / 64 + 1, lam, P.in[18], true);
    }
    xcd_barrier(xbar);
    { pg8::Gemm g{Qb, WAC, M, 2048, D, CB, 4}; PairOrder S{G, bid, 0, PMP * 4}; EpiMerge E{GA, GB, MRG}; GEMM_PHASE(EpiMerge, PairOrder, g, S, E); }
    xcd_barrier(xbar);
    { pg8::Gemm g{MRG, WM, M, D, D, MRG, 1 << 30}; SkipOrder S{G, bid, ns, PMP * 4}; EpiYSsq E{YRAW, ssq + M}; GEMM_PHASE(EpiYSsq, SkipOrder, g, S, E); }
    { pg8::Gemm g{Qb, WAC, M, 2048, D, CB, 4}; PairOrder S{G, bid, PMP, PMS * 4}; EpiMerge E{GAs, GBs, MRG}; GEMM_PHASE(EpiMerge, PairOrder, g, S, E); }
    xcd_barrier(xbar);
    if (doG) GEMM_R(EpiYSsq, MRG, WM, D, D, PMP, PMS, Gs, YRAW, ssq + M);
    if (doE) ew_rows<false, false>(P, YRAW, ssq + M, P.in[11], 1.0f, H, ssqx + 2 * M, 0, MP, gwE, NGWE, lane);
    xcd_barrier(xbar);
    ew_rows<false, false>(P, YRAW, ssq + M, P.in[11], 1.0f, H, ssqx + 2 * M, MP, M, gw, NGW, lane);
    GEMM_R(EpiSwiGLU, H, WGU2, 2 * FF, D, 0, PMP, G, HFF, ssqx + 2 * M);
    xcd_barrier(xbar);
    GEMM_R(EpiYSsq, HFF, WD2, D, FF, 0, PMP, G, YRAW, ssq + 2 * M);
    GEMM_R(EpiSwiGLU, H, WGU2, 2 * FF, D, PMP, PMS, G, HFF, ssqx + 2 * M);
    xcd_barrier(xbar);
    if (doG) GEMM_R(EpiYSsq, HFF, WD2, D, FF, PMP, PMS, Gs, YRAW, ssq + 2 * M);
    if (doE) ew_rows<false, true>(P, YRAW, ssq + 2 * M, P.in[25], 0.5f, H, ssqx, 0, MP, gwE, NGWE, lane);
    xcd_barrier(xbar);
    ew_rows<false, true>(P, YRAW, ssq + 2 * M, P.in[25], 0.5f, H, ssqx, MP, M, gw, NGW, lane);
#undef GEMM_R
}

extern "C" void kernel_launch(void* const* d_in, const int* in_sizes, int n_in, void* d_out, int out_size, void* d_ws, size_t ws_size, hipStream_t stream) {
    static int grid = 0;
    if (grid == 0) {
        if (n_in != 29 || ws_size < WS_END + 8 * MiB) { fprintf(stderr, "kernel_launch: expected 29 inputs and >= %zu bytes of workspace, got %d / %zu\n", (size_t)WS_END, n_in, ws_size); grid = -1; return; }
        int dev = 0, cus = 0, per_cu = 0;
        hipGetDevice(&dev); hipDeviceGetAttribute(&cus, hipDeviceAttributeMultiprocessorCount, dev);
        if (hipFuncSetAttribute((const void*)mk_fwd, hipFuncAttributeMaxDynamicSharedMemorySize, LDS_BYTES) != hipSuccess) fprintf(stderr, "kernel_launch: hipFuncSetAttribute failed\n");
        if (hipOccupancyMaxActiveBlocksPerMultiprocessor(&per_cu, (const void*)mk_fwd, 512, LDS_BYTES) != hipSuccess || per_cu < 1) { fprintf(stderr, "kernel_launch: occupancy query gave %d\n", per_cu); per_cu = 1; }
        (void)hipGetLastError();
        grid = cus * per_cu;
    }
    if (grid < 0) return;
    Params p{};
    for (int i = 0; i < 29; ++i) p.in[i] = (const float*)d_in[i];
    p.out = (float*)d_out; p.ws = (unsigned char*)d_ws; p.nrep = 1;
    if (hipMemsetAsync((char*)d_ws + WS_BAR, 0, XCD_BAR_WORDS * 4, stream) != hipSuccess) fprintf(stderr, "kernel_launch: memset of barrier words failed\n");
    void* args[] = {&p};
    hipError_t e = hipLaunchCooperativeKernel((const void*)mk_fwd, dim3(grid), dim3(512), args, LDS_BYTES, stream);
    if (e != hipSuccess) fprintf(stderr, "cooperative launch failed: %s (grid %d)\n", hipGetErrorString(e), grid);
}
```
